# Optimizing an MI355X kernel written in HIP

```python
import jax
import jax.numpy as jnp
from jax import lax
import numpy as np

D_MODEL = 2048
BATCH = 2
SEQ = 4096
DEPTH = 4
DEC_BATCH = 8
DEC_SEQ = 8
PAST_LEN = 16384
PAGE_SIZE = 128

N_A_LAYERS = DEPTH // 2
N_B_LAYERS = DEPTH - N_A_LAYERS
POOL_WINDOWS = (2, 4, 8, 16)
POOL_GROUP = D_MODEL // len(POOL_WINDOWS)
POOL_KEEP = max(POOL_WINDOWS) - 1
N_HEADS = 16
N_KV_HEADS = 4
HEADS_PER_GROUP = N_HEADS // N_KV_HEADS
HEAD_DIM = D_MODEL // N_HEADS
N_BRANCH = 3
CMP_BLOCK = 32
CMP_STRIDE = 16
CMP_HIDDEN = HEAD_DIM
SEL_BLOCK = 64
N_SEL = 16
WINDOW = 512
FORCE_BONUS = 1e4
D_FF = 5632
CONV_WIDTH = 3
Q_BLOCK = 128
EPS = 1e-6
NEG_INF = -1e30
Q_WIDTH = N_HEADS * HEAD_DIM
KV_WIDTH = N_BRANCH * 2 * N_KV_HEADS * HEAD_DIM

kernel_name = "yoco_pool_nsa_convffn_step"


def rmsnorm(x, g):
    x32 = x.astype(jnp.float32)
    y = x32 * lax.rsqrt(jnp.mean(x32 * x32, axis=-1, keepdims=True) + EPS)
    return (y * g.astype(jnp.float32)).astype(x.dtype)


def alibi_slopes():
    s = np.array([2.0 ** (-8.0 * (h + 1) / N_HEADS) for h in range(N_HEADS)], np.float32)
    return s.reshape(N_KV_HEADS, HEADS_PER_GROUP)


def masked_softmax(s, mask, axes):
    s = jnp.where(mask, s, NEG_INF)
    m = jnp.max(s, axis=axes, keepdims=True)
    p = jnp.where(mask, jnp.exp(s - m), 0.0)
    den = jnp.sum(p, axis=axes, keepdims=True)
    return p / jnp.where(den > 0, den, 1.0)


def pool_mixer(u, prefix, n_prev, w_pool, scale):
    B, T, _ = u.shape
    u32 = u.astype(jnp.float32)
    ctx = jnp.concatenate([prefix.astype(jnp.float32), u32], axis=1)
    cs = jnp.concatenate([jnp.zeros((B, 1, D_MODEL), jnp.float32), jnp.cumsum(ctx, axis=1)], axis=1)
    end = cs[:, POOL_KEEP + 1:]
    t = jnp.arange(T)
    outs = []
    for g, w in enumerate(POOL_WINDOWS):
        sl = slice(g * POOL_GROUP, (g + 1) * POOL_GROUP)
        start = cs[:, POOL_KEEP + 1 - w:POOL_KEEP + 1 - w + T, sl]
        cnt = jnp.minimum(w, n_prev + t + 1).astype(jnp.float32)[None, :, None]
        outs.append((end[..., sl] - start) / cnt - u32[..., sl])
    pooled = jnp.stack(outs, axis=2).astype(u.dtype)
    mixed = jnp.einsum('btgc,gcd->btgd', pooled, w_pool).reshape(B, T, D_MODEL)
    return mixed * scale, ctx[:, -POOL_KEEP:].astype(u.dtype)


def conv_ffn(u, prefix, w_in, conv_w, conv_b, w_out):
    T = u.shape[1]
    h = jnp.einsum('btd,df->btf', u, w_in)
    hp = jnp.concatenate([prefix.astype(h.dtype), h], axis=1)
    c = conv_b + conv_w[0] * hp[:, 0:T] + conv_w[1] * hp[:, 1:T + 1] + conv_w[2] * hp[:, 2:T + 2]
    gate, val = jnp.split(c, 2, axis=-1)
    y = jnp.einsum('btf,fd->btd', jax.nn.silu(gate) * val, w_out)
    return y, hp[:, -(CONV_WIDTH - 1):]


def kv_project(x, ln_kv, w_kv, k_norm):
    B, T, _ = x.shape
    h = rmsnorm(x, ln_kv)
    kv = jnp.einsum('btd,de->bte', h, w_kv).reshape(B, T, N_BRANCH, 2, N_KV_HEADS, HEAD_DIM)
    kv_cmp = kv[:, :, 0]
    kv_sel = jnp.stack([rmsnorm(kv[:, :, 1, 0], k_norm[1]), kv[:, :, 1, 1]], axis=2)
    kv_win = jnp.stack([rmsnorm(kv[:, :, 2, 0], k_norm[2]), kv[:, :, 2, 1]], axis=2)
    return kv_cmp, kv_sel, kv_win


def compress(kv_full, cmp_w1, cmp_pos, cmp_w2, k_norm_cmp):
    B, T = kv_full.shape[:2]
    n_ch = T // CMP_STRIDE
    ch = kv_full[:, :n_ch * CMP_STRIDE].reshape(B, n_ch, CMP_STRIDE, 2, N_KV_HEADS, HEAD_DIM)
    pa = jnp.einsum('bnsvgd,vsdh->bnvgh', ch, cmp_w1[:, :CMP_STRIDE])
    pb = jnp.einsum('bnsvgd,vsdh->bnvgh', ch, cmp_w1[:, CMP_STRIDE:])
    bias = jnp.einsum('vsd,vsdh->vh', cmp_pos, cmp_w1)
    hid = jax.nn.gelu(pa[:, :-1] + pb[:, 1:] + bias[:, None, :])
    out = jnp.einsum('bnvgh,vhd->bnvgd', hid, cmp_w2)
    kc = rmsnorm(out[:, :, 0], k_norm_cmp)
    vc = out[:, :, 1]
    return kc, vc


def to_blocks(kv_sel):
    B, T = kv_sel.shape[:2]
    nb = -(-T // SEL_BLOCK)
    kvp = jnp.pad(kv_sel, ((0, 0), (0, nb * SEL_BLOCK - T), (0, 0), (0, 0), (0, 0)))
    kvb = kvp.reshape(B, nb, SEL_BLOCK, 2, N_KV_HEADS, HEAD_DIM).transpose(3, 0, 4, 1, 2, 5)
    return kvb[0], kvb[1]


def cmp_to_sel_map(nc, nb):
    c_s = np.arange(nc) * CMP_STRIDE
    c_e = c_s + CMP_BLOCK - 1
    s_s = np.arange(nb) * SEL_BLOCK
    s_e = s_s + SEL_BLOCK - 1
    return ((c_s[:, None] <= s_e[None]) & (c_e[:, None] >= s_s[None])).astype(np.float32)


def nsa_queries(h, w_qg, q_norm):
    B, T, _ = h.shape
    qg = jnp.einsum('btd,de->bte', h, w_qg)
    q = rmsnorm(qg[..., :Q_WIDTH].reshape(B, T, N_KV_HEADS, HEADS_PER_GROUP, HEAD_DIM), q_norm)
    q = (q * (HEAD_DIM ** -0.5)).transpose(0, 2, 3, 1, 4)
    gates = jax.nn.sigmoid(qg[..., Q_WIDTH:].astype(jnp.float32)).astype(h.dtype)
    return q, gates.reshape(B, T, N_HEADS, N_BRANCH)


def nsa_attend(q, gates, pos_q, kc, vc, k_blocks, v_blocks, k_w, v_w, pos_w):
    B, G, R, Q, _ = q.shape
    slopes = jnp.asarray(alibi_slopes())[None, :, :, None, None]
    nc = kc.shape[1]
    nb = k_blocks.shape[2]
    pos_c = jnp.arange(nc) * CMP_STRIDE + (CMP_BLOCK - 1)
    dist_c = pos_q[:, None] - pos_c[None, :]
    s_c = jnp.einsum('bgrqd,bcgd->bgrqc', q, kc).astype(jnp.float32) - slopes * dist_c.astype(jnp.float32)
    p_c = masked_softmax(s_c, dist_c >= 0, -1)
    o_c = jnp.einsum('bgrqc,bcgd->bgrqd', p_c.astype(vc.dtype), vc)
    imp = jnp.einsum('bgrqc,cj->bgqj', p_c, jnp.asarray(cmp_to_sel_map(nc, nb)))
    blk = jnp.arange(nb)
    cur = pos_q // SEL_BLOCK
    forced = (blk[None] == 0) | (blk[None] == cur[:, None]) | (blk[None] == cur[:, None] - 1)
    valid = blk[None] * SEL_BLOCK <= pos_q[:, None]
    imp = jnp.where(valid, jnp.where(forced, imp + FORCE_BONUS, imp), NEG_INF)
    _, idx = lax.top_k(imp, min(N_SEL, nb))
    bi = jnp.arange(B)[:, None, None, None]
    gi = jnp.arange(G)[None, :, None, None]
    k_s = k_blocks[bi, gi, idx]
    v_s = v_blocks[bi, gi, idx]
    pos_s = idx[..., None] * SEL_BLOCK + jnp.arange(SEL_BLOCK)
    dist_s = (pos_q[None, None, :, None, None] - pos_s)[:, :, None]
    s_s = jnp.einsum('bgrqd,bgqksd->bgrqks', q, k_s).astype(jnp.float32) - slopes[..., None] * dist_s.astype(jnp.float32)
    p_s = masked_softmax(s_s, dist_s >= 0, (-2, -1))
    o_s = jnp.einsum('bgrqks,bgqksd->bgrqd', p_s.astype(v_s.dtype), v_s)
    dist_w = pos_q[:, None] - pos_w[None, :]
    mask_w = (dist_w >= 0) & (dist_w < WINDOW) & (pos_w[None, :] >= 0)
    s_w = jnp.einsum('bgrqd,bkgd->bgrqk', q, k_w).astype(jnp.float32) - slopes * dist_w.astype(jnp.float32)
    p_w = masked_softmax(s_w, mask_w, -1)
    o_w = jnp.einsum('bgrqk,bkgd->bgrqd', p_w.astype(v_w.dtype), v_w)
    g = gates.reshape(B, Q, G, R, N_BRANCH).transpose(0, 2, 3, 1, 4)
    o = g[..., 0:1] * o_c + g[..., 1:2] * o_s + g[..., 2:3] * o_w
    return o.transpose(0, 3, 1, 2, 4).reshape(B, Q, Q_WIDTH)


def nsa_prompt(q, gates, kc, vc, kb, vb, kv_win):
    B = q.shape[0]
    T = q.shape[3]
    kw = jnp.pad(kv_win, ((0, 0), (WINDOW, 0), (0, 0), (0, 0), (0, 0)))

    def one_block(i):
        s0 = i * Q_BLOCK
        qb = lax.dynamic_slice_in_dim(q, s0, Q_BLOCK, axis=3)
        gb = lax.dynamic_slice_in_dim(gates, s0, Q_BLOCK, axis=1)
        wb = lax.dynamic_slice_in_dim(kw, s0, WINDOW + Q_BLOCK, axis=1)
        pos_q = s0 + jnp.arange(Q_BLOCK)
        pos_w = s0 - WINDOW + jnp.arange(WINDOW + Q_BLOCK)
        return nsa_attend(qb, gb, pos_q, kc, vc, kb, vb, wb[:, :, 0], wb[:, :, 1], pos_w)

    out = lax.map(one_block, jnp.arange(T // Q_BLOCK))
    return out.transpose(1, 0, 2, 3).reshape(B, T, Q_WIDTH)


def trunk(x, n_prev, pool_prefix, conv_prefix, kv_cmp_past, kv_sel_past, kv_win_past, p):
    is_prompt = kv_cmp_past is None
    B, T, _ = x.shape
    pool_rows, conv_rows = [], []
    for l in range(DEPTH):
        h = rmsnorm(x, p['ln_mix'][l])
        if l < N_A_LAYERS:
            mix, rows = pool_mixer(h, pool_prefix[l], n_prev, p['w_pool'][l], p['pool_scale'][l])
            pool_rows.append(rows)
        else:
            if l == N_A_LAYERS:
                cmp_new, sel_new, win_new = kv_project(x, p['ln_kv'], p['w_kv'], p['k_norm'])
                if is_prompt:
                    cmp_full, sel_full, win_keys = cmp_new, sel_new, win_new
                else:
                    cmp_full = jnp.concatenate([kv_cmp_past, cmp_new], axis=1)
                    sel_full = jnp.concatenate([kv_sel_past, sel_new], axis=1)
                    win_keys = jnp.concatenate([kv_win_past, win_new], axis=1)
                kc, vc = compress(cmp_full, p['cmp_w1'], p['cmp_pos'], p['cmp_w2'], p['k_norm'][0])
                kb, vb = to_blocks(sel_full)
                win_state = win_keys[:, win_keys.shape[1] - min(WINDOW, n_prev + T):]
            j = l - N_A_LAYERS
            q, gates = nsa_queries(h, p['w_qg'][j], p['q_norm'][j])
            if is_prompt:
                o = nsa_prompt(q, gates, kc, vc, kb, vb, win_keys)
            else:
                pos_q = n_prev + jnp.arange(T)
                pos_w = n_prev - kv_win_past.shape[1] + jnp.arange(win_keys.shape[1])
                o = nsa_attend(q, gates, pos_q, kc, vc, kb, vb, win_keys[:, :, 0], win_keys[:, :, 1], pos_w)
            mix = jnp.einsum('bte,ed->btd', o, p['w_o'][j])
        x = x + mix
        h = rmsnorm(x, p['ln_ffn'][l])
        y, rows = conv_ffn(h, conv_prefix[l], p['w_in'][l], p['conv_w'][l], p['conv_b'][l], p['w_out'][l])
        conv_rows.append(rows)
        x = x + y
    return x, cmp_new, sel_new, win_state, jnp.stack(pool_rows), jnp.stack(conv_rows)


def setup_inputs(seed: int = 0) -> dict:
    key = jax.random.key(seed)
    ks = jax.random.split(key, 26)
    f32 = jnp.float32

    def nrm(k, shape, scale=1.0):
        return jax.random.normal(k, shape, f32) * scale

    n_pages = PAST_LEN // PAGE_SIZE
    n_used = DEC_BATCH * n_pages
    n_phys = n_used + max(1, n_used // 4)
    win_buf = min(WINDOW, PAST_LEN)
    page_table = jax.random.permutation(ks[0], n_phys)[:n_used].reshape(DEC_BATCH, n_pages).astype(jnp.int32)
    row = (2, N_KV_HEADS, HEAD_DIM)
    return {
        'x_prompt': nrm(ks[1], (BATCH, SEQ, D_MODEL)),
        'x_sample': nrm(ks[2], (DEC_BATCH, DEC_SEQ, D_MODEL)),
        'cache_kv_cmp': nrm(ks[3], (n_phys, PAGE_SIZE) + row),
        'cache_kv_sel': nrm(ks[4], (n_phys, PAGE_SIZE) + row),
        'page_table': page_table,
        'state_kv_win': nrm(ks[5], (DEC_BATCH, win_buf) + row),
        'state_pool': nrm(ks[6], (N_A_LAYERS, DEC_BATCH, POOL_KEEP, D_MODEL)),
        'state_conv': nrm(ks[7], (DEPTH, DEC_BATCH, CONV_WIDTH - 1, 2 * D_FF)),
        'ln_mix': 1.0 + nrm(ks[8], (DEPTH, D_MODEL), 0.02),
        'ln_ffn': 1.0 + nrm(ks[9], (DEPTH, D_MODEL), 0.02),
        'w_pool': nrm(ks[10], (N_A_LAYERS, len(POOL_WINDOWS), POOL_GROUP, POOL_GROUP), POOL_GROUP ** -0.5),
        'pool_scale': 0.3 + nrm(ks[11], (N_A_LAYERS, D_MODEL), 0.02),
        'ln_kv': 1.0 + nrm(ks[12], (D_MODEL,), 0.02),
        'w_kv': nrm(ks[13], (D_MODEL, KV_WIDTH), D_MODEL ** -0.5),
        'k_norm': 1.0 + nrm(ks[14], (N_BRANCH, HEAD_DIM), 0.02),
        'cmp_w1': nrm(ks[15], (2, CMP_BLOCK, HEAD_DIM, CMP_HIDDEN), (CMP_BLOCK * HEAD_DIM) ** -0.5),
        'cmp_pos': nrm(ks[16], (2, CMP_BLOCK, HEAD_DIM), 0.1),
        'cmp_w2': nrm(ks[17], (2, CMP_HIDDEN, HEAD_DIM), CMP_HIDDEN ** -0.5),
        'w_qg': nrm(ks[18], (N_B_LAYERS, D_MODEL, Q_WIDTH + N_BRANCH * N_HEADS), D_MODEL ** -0.5),
        'q_norm': 1.0 + nrm(ks[19], (N_B_LAYERS, HEAD_DIM), 0.02),
        'w_o': nrm(ks[20], (N_B_LAYERS, Q_WIDTH, D_MODEL), Q_WIDTH ** -0.5),
        'w_in': nrm(ks[21], (DEPTH, D_MODEL, 2 * D_FF), D_MODEL ** -0.5),
        'conv_w': nrm(ks[22], (DEPTH, CONV_WIDTH, 2 * D_FF), CONV_WIDTH ** -0.5),
        'conv_b': nrm(ks[23], (DEPTH, 2 * D_FF), 0.01),
        'w_out': nrm(ks[24], (DEPTH, D_FF, D_MODEL), D_FF ** -0.5),
    }


def reference(x_prompt, x_sample, cache_kv_cmp, cache_kv_sel, page_table, state_kv_win, state_pool, state_conv,
              ln_mix, ln_ffn, w_pool, pool_scale, ln_kv, w_kv, k_norm, cmp_w1, cmp_pos, cmp_w2,
              w_qg, q_norm, w_o, w_in, conv_w, conv_b, w_out):
    p = dict(ln_mix=ln_mix, ln_ffn=ln_ffn, w_pool=w_pool, pool_scale=pool_scale, ln_kv=ln_kv, w_kv=w_kv,
             k_norm=k_norm, cmp_w1=cmp_w1, cmp_pos=cmp_pos, cmp_w2=cmp_w2, w_qg=w_qg, q_norm=q_norm,
             w_o=w_o, w_in=w_in, conv_w=conv_w, conv_b=conv_b, w_out=w_out)
    b_p = x_prompt.shape[0]
    b_d, n_pages = page_table.shape
    past_len = n_pages * PAGE_SIZE
    pool_zero = jnp.zeros((N_A_LAYERS, b_p, POOL_KEEP, D_MODEL), x_prompt.dtype)
    conv_zero = jnp.zeros((DEPTH, b_p, CONV_WIDTH - 1, 2 * D_FF), x_prompt.dtype)
    y_prompt, cmp_p, sel_p, win_p, pool_p, conv_p = trunk(x_prompt, 0, pool_zero, conv_zero, None, None, None, p)
    past_cmp = cache_kv_cmp[page_table].reshape((b_d, past_len) + cache_kv_cmp.shape[2:])
    past_sel = cache_kv_sel[page_table].reshape((b_d, past_len) + cache_kv_sel.shape[2:])
    y_sample, cmp_s, sel_s, win_s, pool_s, conv_s = trunk(x_sample, past_len, state_pool, state_conv,
                                                          past_cmp, past_sel, state_kv_win, p)
    return (y_prompt, y_sample, cmp_p, cmp_s, sel_p, sel_s, win_p, win_s, pool_p, pool_s, conv_p, conv_s)
```

```cpp
#include <hip/hip_runtime.h>
#include <cstdio>
#include <cstdint>

#define GAS __attribute__((address_space(1)))
#define LAS __attribute__((address_space(3)))
typedef unsigned short bf16_t;
typedef short bf16x8 __attribute__((ext_vector_type(8)));
typedef short s16x4 __attribute__((ext_vector_type(4)));
typedef float f32x2 __attribute__((ext_vector_type(2)));
typedef float f32x4 __attribute__((ext_vector_type(4)));
typedef float f32x8 __attribute__((ext_vector_type(8)));
typedef float f32x16 __attribute__((ext_vector_type(16)));
typedef unsigned u32x2 __attribute__((ext_vector_type(2)));
typedef unsigned u32x4 __attribute__((ext_vector_type(4)));
typedef unsigned long long u64;

constexpr int D = 2048, SEQ = 4096, NBP = 2, NBS = 8, TS = 8, PAST = 16384;
constexpr int MP = NBP * SEQ, MS = NBS * TS, MR = MP + MS, MPAD = 8448, NTM = MPAD / 256;
constexpr int FF = 5632, FF2 = 11264, NG = 4, HD = 128;
constexpr int KVW = 3072, QGW = 2096, QGP = 2304;
constexpr int NCP = 255, NCS = 1023;
constexpr float EPS = 1e-6f;
constexpr int NWAVES = 8, NTHR = 512;

constexpr size_t O_Y = 0, O_CMPP = 16908288, O_CMPS = 25296896, O_SELP = 25362432, O_SELS = 33751040, O_WINP = 33816576, O_WINS = 34865152,
                 O_POOLP = 39059456, O_POOLS = 39182336, O_CONVP = 39673856, O_CONVS = 39854080, O_END = 40574976;

constexpr size_t MiB = 1u << 20;
constexpr size_t WS_CTL = 0, CTL_ZERO_BYTES = 1 * MiB;
constexpr size_t WS_ROWP = 2 * MiB;
constexpr size_t ROWP_STRIDE = 2 * MiB;
constexpr size_t WS_WPOOL = 18 * MiB;
constexpr size_t WS_WIN = 22 * MiB;
constexpr size_t WS_WOUT = 198 * MiB;
constexpr size_t WS_WKVQG = 286 * MiB;
constexpr size_t WS_WQG1 = 307 * MiB;
constexpr size_t WS_WO = 316 * MiB;
constexpr size_t WS_W1CAT = 332 * MiB;
constexpr size_t WS_W2T = 334 * MiB;
constexpr size_t WS_CBIAS = 334 * MiB + 256 * 1024;
constexpr size_t WS_X = 335 * MiB;
constexpr size_t WS_XB = 401 * MiB;
constexpr size_t WS_POOLED = 434 * MiB;
constexpr size_t WS_HH = 467 * MiB;
constexpr size_t WS_ACT = 649 * MiB;
constexpr size_t WS_KV = 740 * MiB;
constexpr size_t WS_QG = 839 * MiB;
constexpr size_t WS_OB = 914 * MiB;
constexpr size_t WS_KSEL = 947 * MiB, WS_VSEL = 955 * MiB, WS_KWIN = 963 * MiB, WS_VWIN = 971 * MiB;
constexpr size_t WS_KCP = 979 * MiB, WS_VCP = 979 * MiB + 512 * 1024;
constexpr size_t WS_KCS = 980 * MiB, WS_VCS = 988 * MiB;
constexpr size_t WS_KWINS = 996 * MiB, WS_VWINS = 1001 * MiB;
constexpr size_t WS_KSELNS = 1006 * MiB, WS_VSELNS = 1006 * MiB + 512 * 1024;
constexpr size_t WS_ACMP = 1007 * MiB;
constexpr size_t WS_PCMP = 1279 * MiB;
constexpr size_t WS_OF32 = 1347 * MiB;
constexpr size_t WS_END = 1413 * MiB;
constexpr int CMP_ROWS = 69632, CMP_ROW_S0 = 4096;

constexpr int CW_TMO = 0, CW_BAR = 4096;

constexpr int RING_BYTES = 131072, LDSCTL_OFF = RING_BYTES, MISC_OFF = LDSCTL_OFF + 320, LDS_BYTES = 147456;

#define LDS_WAIT() asm volatile("s_waitcnt lgkmcnt(0)" ::: "memory")
#define VM_WAIT() asm volatile("s_waitcnt vmcnt(0)" ::: "memory")
#define SBAR() __builtin_amdgcn_sched_barrier(0)
__device__ __forceinline__ unsigned cvt_pk_bf16(float lo, float hi) { unsigned r; asm volatile("v_cvt_pk_bf16_f32 %0, %1, %2" : "=v"(r) : "v"(lo), "v"(hi)); return r; }
__device__ __forceinline__ float bf2f(bf16_t v) { return __uint_as_float((unsigned)v << 16); }
__device__ __forceinline__ float wave_sum(float v) {
#pragma unroll
    for (int o = 1; o < 64; o <<= 1) v += __shfl_xor(v, o);
    return v;
}

#define XB_TMO      128
#define XB_XCNT(j)  (256  + 64 * (j))
#define XB_XSUB(j)  (1280 + 64 * (j))
#define XB_XGEN(j)  (2304 + 64 * (j))
#define XB_TOP      3328
#define XB_TOPGEN   3392
#define XCD_BAR_WORDS 3456
#define XB_SPIN_CAP (1u << 18)
__device__ __forceinline__ unsigned xb_ld(unsigned* p)              { return __hip_atomic_load(p, __ATOMIC_RELAXED, __HIP_MEMORY_SCOPE_AGENT); }
__device__ __forceinline__ unsigned xb_add(unsigned* p, unsigned v) { return __hip_atomic_fetch_add(p, v, __ATOMIC_RELAXED, __HIP_MEMORY_SCOPE_AGENT); }
__device__ __forceinline__ unsigned xb_xcc_id() { return (unsigned)__builtin_amdgcn_s_getreg((3 << 11) | 20) & 0xFu; }
#define XB_SPIN(cond, bar) do { unsigned _sp = 0; while (cond) { __builtin_amdgcn_s_sleep(1); \
    if ((++_sp & 255u) == 0u) { if (xb_ld(&(bar)[XB_TMO])) break; if (_sp > XB_SPIN_CAP) { atomicAdd(&(bar)[XB_TMO], 1u); break; } } } } while (0)
struct XcdBarrier { unsigned* bar; unsigned x; volatile LAS unsigned* st; };
__device__ __forceinline__ XcdBarrier xcd_barrier_post(unsigned* bar, volatile LAS unsigned* st) {
    XcdBarrier b; b.bar = bar; b.x = xb_xcc_id(); b.st = st;
    if (threadIdx.x == 0) (void)xb_add(&bar[XB_XCNT(b.x)], 1u);
    return b;
}
__device__ __forceinline__ void xcd_barrier_complete(unsigned* bar, unsigned x, unsigned& nloc, unsigned& nx) {
    const unsigned G = gridDim.x * gridDim.y * gridDim.z;
    unsigned sum, cnt, mine, sp = 0u;
    for (;;) {
        sum = 0u; cnt = 0u; mine = 0u;
#pragma unroll
        for (unsigned j = 0; j < 16; ++j) { const unsigned c = xb_ld(&bar[XB_XCNT(j)]); sum += c; cnt += (c > 0u) ? 1u : 0u; mine = (j == x) ? c : mine; }
        if (sum == G) break;
        __builtin_amdgcn_s_sleep(1);
        if ((++sp & 255u) == 0u) { if (xb_ld(&bar[XB_TMO])) break; if (sp > XB_SPIN_CAP) { atomicAdd(&bar[XB_TMO], 1u); break; } }
    }
    nloc = mine > 0u ? mine : 1u; nx = cnt > 0u ? cnt : 1u;
}
__device__ __forceinline__ void xcd_barrier(const XcdBarrier& b) {
    asm volatile("s_waitcnt vmcnt(0)" ::: "memory");
    __syncthreads();
    if (threadIdx.x == 0) {
        unsigned* bar = b.bar; asm volatile("" : "+s"(bar));
        const unsigned bx_ = xb_xcc_id();
        __builtin_amdgcn_s_waitcnt(0);
        unsigned nloc = b.st[0], nx = b.st[1];
        if (nloc == 0u) { xcd_barrier_complete(bar, bx_, nloc, nx); b.st[0] = nloc; b.st[1] = nx; }
        const unsigned old = xb_add(&bar[XB_XSUB(bx_)], 1u);
        const unsigned gen = old / nloc;
        if (old + 1u == (gen + 1u) * nloc) {
            __builtin_amdgcn_fence(__ATOMIC_RELEASE, "agent");
            asm volatile("s_waitcnt vmcnt(0)" ::: "memory");
            const unsigned og = xb_add(&bar[XB_TOP], 1u);
            const unsigned tg = og / nx;
            if (og + 1u == (tg + 1u) * nx) xb_add(&bar[XB_TOPGEN], 1u);
            else XB_SPIN(xb_ld(&bar[XB_TOPGEN]) == tg, bar);
            __builtin_amdgcn_fence(__ATOMIC_ACQUIRE, "agent");
            xb_add(&bar[XB_XGEN(bx_)], 1u);
            asm volatile("s_waitcnt vmcnt(0)" ::: "memory");
        } else {
            XB_SPIN(xb_ld(&bar[XB_XGEN(bx_)]) == gen, bar);
            __builtin_amdgcn_fence(__ATOMIC_ACQUIRE, "agent");
            asm volatile("s_waitcnt vmcnt(0)" ::: "memory");
        }
    }
    __syncthreads();
}

namespace pg8 {
constexpr int BM = 256, BK = 64, HALF = 128, HTB = HALF * BK * 2, STAGE_BYTES = 8 * HTB, NXCD = 8, WGM = 8;
__host__ __device__ __forceinline__ int lds_byte(int r, int c) { const int st = (r >> 4) * 2 + (c >> 5), rr = r & 15, cc = c & 31, ob = rr * 64 + cc * 2; return st * 1024 + (ob ^ (((ob >> 9) & 1) << 5)); }
__host__ __device__ __forceinline__ void stage_rc(int b, int& R, int& C) { const int st = b / 1024, sb = b % 1024, swz = sb ^ (((sb >> 9) & 1) << 5); R = (st >> 1) * 16 + swz / 64; C = (st & 1) * 32 + (swz % 64) / 2; }
__host__ __device__ __forceinline__ int perm32(int rho) { const int n = rho >> 4, i = rho & 15; return 8 * (i >> 2) + 4 * n + (i & 3); }
struct Unit { int pm, pn; };
struct Order {
    int nM, nN, nwg, G, c;
    __device__ __forceinline__ void init(int nM_, int nN_, int G_, int c_) { nM = nM_; nN = nN_; nwg = nM * nN; G = G_; c = c_; }
    __device__ __forceinline__ bool next(int i, Unit& u) const {
        const long L = (long)i * G + c; if (L >= nwg) return false;
        int wgid = (int)L; { const int q = nwg / NXCD, r = nwg % NXCD, xcd = wgid % NXCD, off = wgid / NXCD; wgid = (xcd < r ? xcd * (q + 1) : r * (q + 1) + (xcd - r) * q) + off; }
        const int nig = WGM * nN, gid = wgid / nig, fm = gid * WGM, gsz = (nM - fm) < WGM ? (nM - fm) : WGM;
        u.pm = fm + ((wgid % nig) % gsz); u.pn = (wgid % nig) / gsz; return true;
    }
};
template <class Epi, class Sched, bool ALIGN_EPI>
__device__ __forceinline__ void gemm_phase(LAS unsigned char* lds, const char* Abase, const char* Bbase, int lda, int ldb, int K, const Sched& S, const Epi& E) {
    int tid = threadIdx.x; asm volatile("" : "+v"(tid));
    const int wid = __builtin_amdgcn_readfirstlane(tid >> 6), lane = tid & 63, wr = wid >> 2, wc = wid & 3, fr = lane & 15, fq = lane >> 4;
    const int nt = K / BK;
    unsigned voffA[2], voffB[2];
#pragma unroll
    for (int i = 0; i < 2; ++i) { int R, C; stage_rc(tid * 16 + i * 8192, R, C); const int Rb = Epi::PERM ? ((R & ~31) + perm32(R & 31)) : R;
        voffA[i] = (unsigned)(R * lda + C) * 2u; voffB[i] = (unsigned)(Rb * ldb + C) * 2u; }
    const size_t kstep = (size_t)(BK * 2);
    const size_t hstepA = (size_t)HALF * lda * 2, hstepB = (size_t)HALF * ldb * 2;
    const unsigned ldsw = (unsigned)wid * 1024u;
    const int aoff = lds_byte(wr * 64 + fr, fq * 8), boff = lds_byte(wc * 32 + fr, fq * 8);
#define PG8_SA(b, h) (((b) * 2 + (h)) * HTB)
#define PG8_SB(b, h) ((4 + (b) * 2 + (h)) * HTB)
#define PG8_STAGE(bufoff, gbase, voff) do { _Pragma("unroll") for (int _i = 0; _i < 2; ++_i) \
        __builtin_amdgcn_global_load_lds((const unsigned*)((const char*)(gbase) + (voff)[_i]), (LAS unsigned*)(lds + (bufoff) + ldsw + _i * 8192), 16, 0, 0); } while (0)
#define PG8_LDA(dst, b, h) do { _Pragma("unroll") for (int m = 0; m < 4; ++m) _Pragma("unroll") for (int k = 0; k < 2; ++k) dst[m][k] = *(const LAS bf16x8*)(lds + PG8_SA(b, h) + aoff + m * 2048 + k * 1024); } while (0)
#define PG8_LDB(dst, b, h) do { _Pragma("unroll") for (int n = 0; n < 2; ++n) _Pragma("unroll") for (int k = 0; k < 2; ++k) dst[n][k] = *(const LAS bf16x8*)(lds + PG8_SB(b, h) + boff + n * 2048 + k * 1024); } while (0)
#define PG8_MMA(ai, bj, At, Bt) do { __builtin_amdgcn_s_setprio(1); _Pragma("unroll") for (int m = 0; m < 4; ++m) _Pragma("unroll") for (int n = 0; n < 2; ++n) _Pragma("unroll") for (int k = 0; k < 2; ++k) \
        acc[ai][bj][m][n] = __builtin_amdgcn_mfma_f32_16x16x32_bf16(Bt[n][k], At[m][k], acc[ai][bj][m][n], 0, 0, 0); __builtin_amdgcn_s_setprio(0); } while (0)
#define PG8_WAIT_V(n) asm volatile("s_waitcnt vmcnt(" #n ")" ::: "memory")
#define PG8_WAIT_L(n) asm volatile("s_waitcnt lgkmcnt(" #n ")" ::: "memory")
#define PG8_BAR __builtin_amdgcn_s_barrier()
#define PG8_SCHED __builtin_amdgcn_sched_barrier(0)
    Unit cur, nxt; int ui = 0;
    if (!S.next(0, cur)) return;
    f32x4 acc[2][2][4][2];
#pragma unroll
    for (int a = 0; a < 2; ++a)
#pragma unroll
        for (int b = 0; b < 2; ++b)
#pragma unroll
            for (int m = 0; m < 4; ++m)
#pragma unroll
                for (int n = 0; n < 2; ++n) acc[a][b][m][n] = (f32x4){0.f, 0.f, 0.f, 0.f};
    bf16x8 At[4][2], B0[2][2], B1[2][2];
    const char* cA = Abase + S.aoff(cur); const char* cB = Bbase + S.boff(cur);
    PG8_STAGE(PG8_SB(0, 0), cB, voffB); PG8_STAGE(PG8_SB(0, 1), cB + hstepB, voffB); PG8_STAGE(PG8_SA(0, 0), cA, voffA); PG8_STAGE(PG8_SA(0, 1), cA + hstepA, voffA);
    if (wr == 1) PG8_BAR;
    PG8_WAIT_V(2); PG8_BAR;
    PG8_STAGE(PG8_SB(1, 0), cB + kstep, voffB); PG8_STAGE(PG8_SA(1, 0), cA + kstep, voffA); PG8_STAGE(PG8_SB(1, 1), cB + hstepB + kstep, voffB);
    PG8_WAIT_V(6); PG8_BAR;
    for (;;) {
        const bool has_next = S.next(ui + 1, nxt);
        const char* nA = has_next ? Abase + S.aoff(nxt) : cA; const char* nB = has_next ? Bbase + S.boff(nxt) : cB;
        for (int t = 0; t < nt; t += 2) {
            const bool last = (t == nt - 2);
            const char* a1 = cA + (size_t)(t + 1) * kstep;
            const char* a2 = last ? nA : cA + (size_t)(t + 2) * kstep; const char* b2 = last ? nB : cB + (size_t)(t + 2) * kstep;
            const char* a3 = a2 + kstep; const char* b3 = b2 + kstep;
            PG8_LDB(B0, 0, 0); PG8_LDB(B1, 0, 1); PG8_SCHED; PG8_LDA(At, 0, 0); PG8_STAGE(PG8_SA(1, 1), a1 + hstepA, voffA);
            PG8_WAIT_V(8); PG8_WAIT_L(0); PG8_BAR; PG8_MMA(0, 0, At, B0); PG8_MMA(0, 1, At, B1); PG8_BAR; PG8_SCHED;
            PG8_LDA(At, 0, 1); PG8_STAGE(PG8_SB(0, 0), b2, voffB); PG8_STAGE(PG8_SB(0, 1), b2 + hstepB, voffB); PG8_STAGE(PG8_SA(0, 0), a2, voffA);
            PG8_WAIT_V(8); PG8_WAIT_L(0); PG8_BAR; PG8_MMA(1, 0, At, B0); PG8_MMA(1, 1, At, B1); PG8_BAR; PG8_SCHED;
            PG8_LDB(B0, 1, 0); PG8_LDB(B1, 1, 1); PG8_SCHED; PG8_LDA(At, 1, 0); PG8_STAGE(PG8_SA(0, 1), a2 + hstepA, voffA);
            PG8_WAIT_V(8); PG8_WAIT_L(0); PG8_BAR; PG8_MMA(0, 0, At, B0); PG8_MMA(0, 1, At, B1); PG8_BAR; PG8_SCHED;
            PG8_LDA(At, 1, 1); PG8_STAGE(PG8_SB(1, 0), b3, voffB); PG8_STAGE(PG8_SB(1, 1), b3 + hstepB, voffB); PG8_STAGE(PG8_SA(1, 0), a3, voffA);
            PG8_WAIT_V(8); PG8_WAIT_L(0); PG8_BAR; PG8_MMA(1, 0, At, B0); PG8_MMA(1, 1, At, B1); PG8_BAR; PG8_SCHED;
        }
        if constexpr (ALIGN_EPI) { if (wr == 0) PG8_BAR; }
        { int fr_ = fr, fq_ = fq; asm volatile("" : "+v"(fr_), "+v"(fq_)); E(acc, cur, wr, wc, fr_, fq_); }
        if (!has_next) break;
#pragma unroll
        for (int a = 0; a < 2; ++a)
#pragma unroll
            for (int b = 0; b < 2; ++b)
#pragma unroll
                for (int m = 0; m < 4; ++m)
#pragma unroll
                    for (int n = 0; n < 2; ++n) acc[a][b][m][n] = (f32x4){0.f, 0.f, 0.f, 0.f};
        cur = nxt; cA = nA; cB = nB; ++ui;
        if constexpr (ALIGN_EPI) { if (wr == 1) PG8_BAR; }
    }
    PG8_WAIT_V(0);
    if constexpr (!ALIGN_EPI) { if (wr == 0) PG8_BAR; }
    PG8_BAR;
#undef PG8_SA
#undef PG8_SB
#undef PG8_STAGE
#undef PG8_LDA
#undef PG8_LDB
#undef PG8_MMA
#undef PG8_WAIT_V
#undef PG8_WAIT_L
#undef PG8_BAR
#undef PG8_SCHED
}
}
using pg8::Unit;

__device__ __forceinline__ float row_rstd(const float* rowp, int m) {
    const f32x4* p = (const f32x4*)(rowp + (size_t)m * 32); float s = 0.f;
#pragma unroll
    for (int i = 0; i < 8; ++i) { const f32x4 v = p[i]; s += (v[0] + v[1]) + (v[2] + v[3]); }
    return 1.0f / sqrtf(s * (1.0f / D) + EPS);
}

__device__ __forceinline__ float row_rstd4(const float* rowp, int m, int fq) {
    const f32x4* p = (const f32x4*)(rowp + (size_t)m * 32 + fq * 8); const f32x4 v0 = p[0], v1 = p[1];
    float s = ((v0[0] + v0[1]) + (v0[2] + v0[3])) + ((v1[0] + v1[1]) + (v1[2] + v1[3]));
    s += __shfl_xor(s, 16); s += __shfl_xor(s, 32);
    return 1.0f / sqrtf(s * (1.0f / D) + EPS);
}
struct SchedPlain {
    pg8::Order o; size_t astep, bstep;
    __device__ __forceinline__ bool next(int i, Unit& u) const { return o.next(i, u); }
    __device__ __forceinline__ size_t aoff(const Unit& u) const { return (size_t)u.pm * astep; }
    __device__ __forceinline__ size_t boff(const Unit& u) const { return (size_t)u.pn * bstep; }
};
struct SchedMix {
    pg8::Order o;
    __device__ __forceinline__ bool next(int i, Unit& u) const { return o.next(i, u); }
    __device__ __forceinline__ size_t aoff(const Unit& u) const { return ((size_t)u.pm * 256 * D + (size_t)(u.pn >> 1) * 512) * 2; }
    __device__ __forceinline__ size_t boff(const Unit& u) const { return ((size_t)(u.pn >> 1) * 512 * 512 + (size_t)(u.pn & 1) * 256 * 512) * 2; }
};
struct SchedCmp {
    pg8::Order o;
    __device__ __forceinline__ bool next(int i, Unit& u) const { return o.next(i, u); }
    __device__ __forceinline__ size_t aoff(const Unit& u) const { return (size_t)u.pm * 256 * 2048 * 2; }
    __device__ __forceinline__ size_t boff(const Unit& u) const { const int v = (u.pm < 8) ? 0 : (u.pm < 16) ? 1 : (u.pm < 144) ? 0 : 1; return (size_t)v * 256 * 2048 * 2; }
};

struct EpiResid {
    static constexpr bool PERM = false;
    const float* xin; float* xout; bf16_t* xb; float* rowp; const float* colscale; int mlimit;
    __device__ __forceinline__ void operator()(const f32x4 (&acc)[2][2][4][2], const Unit& u, int wr, int wc, int fr, int fq) const {
        const int col0 = u.pn * 256 + wc * 32 + 4 * fq;
        f32x4 cs[2][2];
#pragma unroll
        for (int bj = 0; bj < 2; ++bj)
#pragma unroll
            for (int n = 0; n < 2; ++n) cs[bj][n] = colscale ? *(const f32x4*)(colscale + col0 + bj * 128 + n * 16) : (f32x4){1.f, 1.f, 1.f, 1.f};
#pragma unroll
        for (int ai = 0; ai < 2; ++ai)
#pragma unroll
            for (int m = 0; m < 4; ++m) {
                const int row = u.pm * 256 + ai * 128 + wr * 64 + m * 16 + fr; const size_t off = (size_t)row * D + col0; float ss = 0.f;
                const bool ok = row < mlimit;
#pragma unroll
                for (int bj = 0; bj < 2; ++bj)
#pragma unroll
                    for (int n = 0; n < 2; ++n) {
                        f32x4 b = ok ? *(const f32x4*)(xin + off + bj * 128 + n * 16) : (f32x4){0.f, 0.f, 0.f, 0.f};
                        const f32x4 v = b + acc[ai][bj][m][n] * cs[bj][n];
                        ss += (v[0] * v[0] + v[1] * v[1]) + (v[2] * v[2] + v[3] * v[3]);
                        if (ok) { *(f32x4*)(xout + off + bj * 128 + n * 16) = v;
                            if (xb) { u32x2 w; w.x = cvt_pk_bf16(v[0], v[1]); w.y = cvt_pk_bf16(v[2], v[3]); *(u32x2*)(xb + off + bj * 128 + n * 16) = w; } }
                    }
                ss += __shfl_xor(ss, 16); ss += __shfl_xor(ss, 32);
                if (rowp && fq == 0 && ok) rowp[(size_t)row * 32 + u.pn * 4 + wc] = ss;
                if (m & 1) asm volatile("" ::: "memory");
            }
    }
};
struct EpiF32 {
    static constexpr bool PERM = false;
    const float* rowp; float* out; int ldo; int split; float* out2; int ldo2;
    __device__ __forceinline__ void operator()(const f32x4 (&acc)[2][2][4][2], const Unit& u, int wr, int wc, int fr, int fq) const {
        float* o = out; int ld = ldo; int pn = u.pn; if (pn >= split) { o = out2; ld = ldo2; pn -= split; }
        const int col0 = pn * 256 + wc * 32 + 4 * fq;
#pragma unroll
        for (int ai = 0; ai < 2; ++ai)
#pragma unroll
            for (int m = 0; m < 4; ++m) {
                const int row = u.pm * 256 + ai * 128 + wr * 64 + m * 16 + fr; const float rs = rowp ? row_rstd4(rowp, row, fq) : 1.0f; const size_t off = (size_t)row * ld + col0;
#pragma unroll
                for (int bj = 0; bj < 2; ++bj)
#pragma unroll
                    for (int n = 0; n < 2; ++n) *(f32x4*)(o + off + bj * 128 + n * 16) = acc[ai][bj][m][n] * rs;
            }
    }
};
struct EpiHH {
    static constexpr bool PERM = true;
    const float* rowp; bf16_t* hh; float* convp; float* convs;
    __device__ __forceinline__ void operator()(const f32x4 (&acc)[2][2][4][2], const Unit& u, int wr, int wc, int fr, int fq) const {
        const int colt = wc * 32 + 8 * fq;
#pragma unroll
        for (int ai = 0; ai < 2; ++ai)
#pragma unroll
            for (int m = 0; m < 4; ++m) {
                const int trow = ai * 128 + wr * 64 + m * 16 + fr, row = u.pm * 256 + trow; const float rs = row_rstd4(rowp, row, fq);
                bf16_t* rowptr = hh + (size_t)row * FF2 + u.pn * 256 + colt;
                float* cdst = nullptr;
                if (u.pm == 32) { if (trow < 64 && (trow & 7) >= 6) cdst = convs + ((size_t)(trow >> 3) * 2 + ((trow & 7) - 6)) * FF2; }
                else if ((u.pm & 15) == 15 && trow >= 254) cdst = convp + ((size_t)(u.pm >> 4) * 2 + (trow - 254)) * FF2;
#pragma unroll
                for (int bj = 0; bj < 2; ++bj) {
                    const f32x4 v0 = acc[ai][bj][m][0] * rs, v1 = acc[ai][bj][m][1] * rs;
                    u32x4 w; w.x = cvt_pk_bf16(v0[0], v0[1]); w.y = cvt_pk_bf16(v0[2], v0[3]); w.z = cvt_pk_bf16(v1[0], v1[1]); w.w = cvt_pk_bf16(v1[2], v1[3]);
                    *(u32x4*)(rowptr + bj * 128) = w;
                    if (cdst) { float* c = cdst + bj * FF + u.pn * 128 + colt; *(f32x4*)c = v0; *(f32x4*)(c + 4) = v1; }
                }
            }
    }
};

struct Args { const void* in[25]; float* out; unsigned char* ws; };
struct Frame {
    LAS unsigned char* lds; int tid, lane, wave, vcu, G;
};

__device__ __forceinline__ void tr_item(const float* W, int ldw, int k0, int nsrc0, int nvalid, const float* kscale, bf16_t* WT, int ldt, int ndst0, LAS float* scr, int lane) {
#pragma unroll 8
    for (int i = 0; i < 32; ++i) { const int kk = 2 * i + (lane >> 5), n = nsrc0 + (lane & 31);
        float v = (n < nvalid) ? W[(size_t)(k0 + kk) * ldw + n] : 0.f; if (kscale) v *= kscale[k0 + kk]; scr[kk * 33 + (lane & 31)] = v; }
    LDS_WAIT(); asm volatile("" ::: "memory");
    const int c = lane & 7;
#pragma unroll
    for (int j = 0; j < 4; ++j) { const int n = (lane >> 3) + 8 * j; const LAS float* s = scr + (8 * c) * 33 + n;
        u32x4 o; o.x = cvt_pk_bf16(s[0 * 33], s[1 * 33]); o.y = cvt_pk_bf16(s[2 * 33], s[3 * 33]); o.z = cvt_pk_bf16(s[4 * 33], s[5 * 33]); o.w = cvt_pk_bf16(s[6 * 33], s[7 * 33]);
        *(u32x4*)(WT + (size_t)(ndst0 + n) * ldt + k0 + 8 * c) = o; }
    LDS_WAIT(); asm volatile("" ::: "memory");
}

__device__ __forceinline__ void p0_prologue(const Args& a, const Frame& F) {
    unsigned char* ws = a.ws;
    LAS float* scr = (LAS float*)(F.lds + F.wave * 16384);
    const int gw = F.vcu * NWAVES + F.wave, NGW = F.G * NWAVES, lane = F.lane;
    const float* ln_mix = (const float*)a.in[8]; const float* ln_ffn = (const float*)a.in[9];
    constexpr int I_POOL = 8 * 8 * 16, I_WIN = 32 * 352, I_WOUT = 88 * 64, I_WKV = 32 * 96, I_WQG = 32 * 72, I_WO = 32 * 64, I_W1 = 32 * 4, I_W2 = 2 * 4;
    constexpr int NITEMS = I_POOL + 4 * I_WIN + 4 * I_WOUT + I_WKV + 2 * I_WQG + 2 * I_WO + 4 * I_W1 + 2 * I_W2;
    for (int it = gw; it < NITEMS; it += NGW) {
        int r = it;
        if (r < I_POOL) { const int mat = r >> 7, q = r & 127, kb = q >> 4, nb = q & 15;
            tr_item((const float*)a.in[10] + (size_t)mat * 512 * 512, 512, kb * 64, nb * 32, 512, nullptr, (bf16_t*)(ws + WS_WPOOL) + (size_t)mat * 512 * 512, 512, nb * 32, scr, lane); continue; } r -= I_POOL;
        if (r < 4 * I_WIN) { const int l = r / I_WIN, q = r % I_WIN, kb = q / 352, nb = q % 352; const int ns = nb * 32;
            const int f = ns < FF ? ns : ns - FF; const int nd = (f >> 7) * 256 + (ns < FF ? 0 : 128) + (f & 127);
            tr_item((const float*)a.in[21] + (size_t)l * D * FF2, FF2, kb * 64, ns, FF2, ln_ffn + l * D, (bf16_t*)(ws + WS_WIN) + (size_t)l * FF2 * D, D, nd, scr, lane); continue; } r -= 4 * I_WIN;
        if (r < 4 * I_WOUT) { const int l = r / I_WOUT, q = r % I_WOUT, kb = q >> 6, nb = q & 63;
            tr_item((const float*)a.in[24] + (size_t)l * FF * D, D, kb * 64, nb * 32, D, nullptr, (bf16_t*)(ws + WS_WOUT) + (size_t)l * D * FF, FF, nb * 32, scr, lane); continue; } r -= 4 * I_WOUT;
        if (r < I_WKV) { const int kb = r / 96, nb = r % 96;
            tr_item((const float*)a.in[13], KVW, kb * 64, nb * 32, KVW, (const float*)a.in[12], (bf16_t*)(ws + WS_WKVQG), D, nb * 32, scr, lane); continue; } r -= I_WKV;
        if (r < 2 * I_WQG) { const int j = r / I_WQG, q = r % I_WQG, kb = q / 72, nb = q % 72;
            bf16_t* dst = j == 0 ? (bf16_t*)(ws + WS_WKVQG) + (size_t)KVW * D : (bf16_t*)(ws + WS_WQG1);
            tr_item((const float*)a.in[18] + (size_t)j * D * QGW, QGW, kb * 64, nb * 32, QGW, ln_mix + (2 + j) * D, dst, D, nb * 32, scr, lane); continue; } r -= 2 * I_WQG;
        if (r < 2 * I_WO) { const int j = r / I_WO, q = r % I_WO, kb = q >> 6, nb = q & 63;
            tr_item((const float*)a.in[20] + (size_t)j * D * D, D, kb * 64, nb * 32, D, nullptr, (bf16_t*)(ws + WS_WO) + (size_t)j * D * D, D, nb * 32, scr, lane); continue; } r -= 2 * I_WO;
        if (r < 4 * I_W1) { const int vh = r / I_W1, q = r % I_W1, kb = q >> 2, nb = q & 3; const int v = vh >> 1, half = vh & 1;
            tr_item((const float*)a.in[15] + ((size_t)(v * 32 + half * 16) * 128) * 128, 128, kb * 64, nb * 32, 128, nullptr, (bf16_t*)(ws + WS_W1CAT) + (size_t)v * 256 * 2048, 2048, half * 128 + nb * 32, scr, lane); continue; } r -= 4 * I_W1;
        { const int v = r / I_W2, q = r % I_W2, kb = q >> 2, nb = q & 3;
            tr_item((const float*)a.in[17] + (size_t)v * 128 * 128, 128, kb * 64, nb * 32, 128, nullptr, (bf16_t*)(ws + WS_W2T) + (size_t)v * 128 * 128, 128, nb * 32, scr, lane); }
    }
    for (int it = gw; it < 256; it += NGW) { const int v = it >> 7, h = it & 127; const float* pos = (const float*)a.in[16] + (size_t)v * 4096; const float* w1 = (const float*)a.in[15] + (size_t)v * 4096 * 128 + h;
        float s = 0.f; for (int i = lane; i < 4096; i += 64) s += pos[i] * w1[(size_t)i * 128];
        s = wave_sum(s); if (lane == 0) ((float*)(ws + WS_CBIAS))[it] = s; }
    { float* X = (float*)(ws + WS_X); float* rowp = (float*)(ws + WS_ROWP);
      for (int m = gw; m < MR; m += NGW) { const float* src = m < MP ? (const float*)a.in[0] + (size_t)m * D : (const float*)a.in[1] + (size_t)(m - MP) * D;
          float s = 0.f;
#pragma unroll
          for (int j = 0; j < 8; ++j) { const f32x4 v = *((const f32x4*)src + lane + 64 * j); *((f32x4*)(X + (size_t)m * D) + lane + 64 * j) = v; s += (v[0] * v[0] + v[1] * v[1]) + (v[2] * v[2] + v[3] * v[3]); }
          s = wave_sum(s); if (lane < 32) rowp[(size_t)m * 32 + lane] = lane == 0 ? s : 0.f; } }
    { const float* cache = (const float*)a.in[2]; const int* pt = (const int*)a.in[4]; bf16_t* ACMP = (bf16_t*)(ws + WS_ACMP);
      for (int it = gw; it < NBS * 1024; it += NGW) { const int b = it >> 10, n = it & 1023; const int page = pt[b * 128 + (n >> 3)];
          const float* src = cache + ((size_t)page * 128 + (n & 7) * 16) * 1024;
#pragma unroll 4
          for (int s = 0; s < 16; ++s)
#pragma unroll
              for (int q = 0; q < 4; ++q) { const f32x4 v = *((const f32x4*)(src + s * 1024 + q * 256) + lane); const int hq = q * 2 + (lane >> 5), vv = hq >> 2, g = hq & 3, d = (lane & 31) * 4;
                  u32x2 w; w.x = cvt_pk_bf16(v[0], v[1]); w.y = cvt_pk_bf16(v[2], v[3]);
                  *(u32x2*)(ACMP + ((size_t)CMP_ROW_S0 + (size_t)vv * 32768 + (size_t)(b * 4 + g) * 1024 + n) * 2048 + s * 128 + d) = w; } } }
    { const float* st = (const float*)a.in[5]; bf16_t* KW = (bf16_t*)(ws + WS_KWINS); bf16_t* VW = (bf16_t*)(ws + WS_VWINS); float* ow = a.out + O_WINS;
      for (int it = gw; it < NBS * 512; it += NGW) { const int b = it >> 9, i = it & 511; const float* src = st + (size_t)it * 1024;
#pragma unroll
          for (int q = 0; q < 4; ++q) { const f32x4 v = *((const f32x4*)(src + q * 256) + lane); const int hq = q * 2 + (lane >> 5), vv = hq >> 2, g = hq & 3, d = (lane & 31) * 4;
              u32x2 w; w.x = cvt_pk_bf16(v[0], v[1]); w.y = cvt_pk_bf16(v[2], v[3]);
              *(u32x2*)((vv ? VW : KW) + ((size_t)(b * 4 + g) * 576 + i) * 128 + d) = w;
              if (i >= 8) *((f32x4*)(ow + ((size_t)b * 512 + (i - 8)) * 1024 + q * 256) + lane) = v; } } }
    { const int gt = gw * 64 + lane, NGT = NGW * 64; const u32x4 z = {0u, 0u, 0u, 0u};
      for (int i = gt; i < (int)(MiB / 16); i += NGT) { *((u32x4*)(ws + WS_KCP) + i) = z; *((u32x4*)(ws + WS_KSELNS) + i) = z; }
      for (int i = gt; i < 32 * 16; i += NGT) { const int bg = i >> 4, c = i & 15; *((u32x4*)(ws + WS_KCS + ((size_t)bg * 1024 + 1023) * 256) + c) = z; *((u32x4*)(ws + WS_VCS + ((size_t)bg * 1024 + 1023) * 256) + c) = z; }
      for (int i = gt; i < 32 * 56 * 16; i += NGT) { const int bg = i / (56 * 16), r = i % (56 * 16); *((u32x4*)(ws + WS_KWINS + ((size_t)bg * 576 + 520) * 256) + r) = z; *((u32x4*)(ws + WS_VWINS + ((size_t)bg * 576 + 520) * 256) + r) = z; } }
}

__device__ __forceinline__ void pool_pass(const Args& a, const Frame& F, int l) {
    unsigned char* ws = a.ws; const float* X = (const float*)(ws + WS_X); const float* rowp = (const float*)(ws + WS_ROWP + (size_t)(2 * l) * ROWP_STRIDE);
    const float* gain = (const float*)a.in[8] + l * D; bf16_t* PO = (bf16_t*)(ws + WS_POOLED);
    LAS float* ctx = (LAS float*)F.lds; LAS float* rs = (LAS float*)(F.lds + 47 * 512 * 4);
    const int tid = F.tid;
    constexpr int NUP = (MP / 32) * 4, NU = NUP + NBS * 4;
    for (int u = F.vcu; u < NU; u += F.G) {
        __syncthreads();
        if (u < NUP) {
            const int g = u & 3, rt = u >> 2, b = rt >> 7, t0 = (rt & 127) * 32, w = 2 << g;
            if (tid < 47) { const int t = t0 - 15 + tid; rs[tid] = t >= 0 ? row_rstd(rowp, b * SEQ + t) : 0.f; }
            __syncthreads();
            { const int c4 = tid & 127; const f32x4 gv = *((const f32x4*)(gain + g * 512) + c4);
              for (int r = tid >> 7; r < 47; r += 4) { const int t = t0 - 15 + r; f32x4 v = {0.f, 0.f, 0.f, 0.f};
                  if (t >= 0) { v = *((const f32x4*)(X + (size_t)(b * SEQ + t) * D + g * 512) + c4); v = v * rs[r] * gv; }
                  *((LAS f32x4*)(ctx + r * 512) + c4) = v; } }
            __syncthreads();
            { const int cp = tid & 255, half = tid >> 8, r0 = 15 + half * 16; float s0 = 0.f, s1 = 0.f;
              for (int i = 1; i < w; ++i) { const f32x2 v = *(const LAS f32x2*)(ctx + (r0 - i) * 512 + 2 * cp); s0 += v[0]; s1 += v[1]; }
              for (int i = 0; i < 16; ++i) { const int r = r0 + i, t = t0 + half * 16 + i; const f32x2 h = *(const LAS f32x2*)(ctx + r * 512 + 2 * cp); s0 += h[0]; s1 += h[1];
                  const float inv = 1.0f / (float)(t + 1 < w ? t + 1 : w);
                  *(unsigned*)(PO + (size_t)(b * SEQ + t) * D + g * 512 + 2 * cp) = cvt_pk_bf16(s0 * inv - h[0], s1 * inv - h[1]);
                  const f32x2 o = *(const LAS f32x2*)(ctx + (r - w + 1) * 512 + 2 * cp); s0 -= o[0]; s1 -= o[1]; } }
            if (t0 == SEQ - 32) { float* op = a.out + O_POOLP + ((size_t)(l * NBP + b) * 15) * D + g * 512;
                for (int i = tid; i < 15 * 512; i += NTHR) { const int r = i >> 9, c = i & 511; op[(size_t)r * D + c] = ctx[(32 + r) * 512 + c]; } }
        } else {
            const int us = u - NUP, g = us & 3, b = us >> 2, w = 2 << g; const float* sp = (const float*)a.in[6] + ((size_t)(l * NBS + b) * 15) * D + g * 512;
            if (tid < 8) rs[tid] = row_rstd(rowp, MP + b * 8 + tid);
            __syncthreads();
            for (int i = tid; i < 23 * 512; i += NTHR) { const int r = i >> 9, c = i & 511;
                ctx[i] = r < 15 ? sp[(size_t)r * D + c] : X[(size_t)(MP + b * 8 + r - 15) * D + g * 512 + c] * rs[r - 15] * gain[g * 512 + c]; }
            __syncthreads();
            { const int c = tid; const float inv = 1.0f / (float)w;
              for (int t = 0; t < 8; ++t) { float s = 0.f; for (int i = 0; i < w; ++i) s += ctx[(15 + t - i) * 512 + c];
                  PO[(size_t)(MP + b * 8 + t) * D + g * 512 + c] = (bf16_t)(cvt_pk_bf16(s * inv - ctx[(15 + t) * 512 + c], 0.f) & 0xffffu); } }
            { float* op = a.out + O_POOLS + ((size_t)(l * NBS + b) * 15) * D + g * 512;
              for (int i = tid; i < 15 * 512; i += NTHR) { const int r = i >> 9, c = i & 511; op[(size_t)r * D + c] = ctx[(8 + r) * 512 + c]; } }
        }
    }
    __syncthreads();
}

__device__ __forceinline__ void convgate_pass(const Args& a, const Frame& F, int l) {
    unsigned char* ws = a.ws; const bf16_t* HH = (const bf16_t*)(ws + WS_HH); bf16_t* ACT = (bf16_t*)(ws + WS_ACT);
    const float* cw = (const float*)a.in[22] + (size_t)l * 3 * FF2; const float* cb = (const float*)a.in[23] + (size_t)l * FF2; const float* sc = (const float*)a.in[7] + (size_t)l * NBS * 2 * FF2;
    const int gw = F.vcu * NWAVES + F.wave, NGW = F.G * NWAVES, lane = F.lane;
    constexpr int NCH_P = MP / 16, NIT = (NCH_P + NBS) * 11;
    for (int it = gw; it < NIT; it += NGW) {
        const int fg = it % 11, ch = it / 11; const int f0 = fg * 512 + lane * 8, pn = f0 >> 7, j0 = f0 & 127;
        const bool samp = ch >= NCH_P; const int bs = ch - NCH_P; const int m0 = samp ? MP + bs * 8 : ch * 16, nrow = samp ? 8 : 16; const bool seq_start = samp || ((ch & 255) == 0);
        float wg[3][8], wv[3][8], bg[8], bv[8];
#pragma unroll
        for (int k = 0; k < 3; ++k) { const f32x4 a0 = *(const f32x4*)(cw + k * FF2 + f0), a1 = *(const f32x4*)(cw + k * FF2 + f0 + 4), c0 = *(const f32x4*)(cw + k * FF2 + FF + f0), c1 = *(const f32x4*)(cw + k * FF2 + FF + f0 + 4);
#pragma unroll
            for (int i = 0; i < 4; ++i) { wg[k][i] = a0[i]; wg[k][4 + i] = a1[i]; wv[k][i] = c0[i]; wv[k][4 + i] = c1[i]; } }
        { const f32x4 a0 = *(const f32x4*)(cb + f0), a1 = *(const f32x4*)(cb + f0 + 4), c0 = *(const f32x4*)(cb + FF + f0), c1 = *(const f32x4*)(cb + FF + f0 + 4);
#pragma unroll
          for (int i = 0; i < 4; ++i) { bg[i] = a0[i]; bg[4 + i] = a1[i]; bv[i] = c0[i]; bv[4 + i] = c1[i]; } }
        float g2[8], g1[8], v2[8], v1[8];
        const size_t colg = (size_t)pn * 256 + j0;
        if (seq_start) {
            if (samp) { const float* p0 = sc + ((size_t)bs * 2 + 0) * FF2, *p1 = sc + ((size_t)bs * 2 + 1) * FF2;
#pragma unroll
                for (int i = 0; i < 8; ++i) { g2[i] = p0[f0 + i]; v2[i] = p0[FF + f0 + i]; g1[i] = p1[f0 + i]; v1[i] = p1[FF + f0 + i]; } }
            else {
#pragma unroll
                for (int i = 0; i < 8; ++i) { g2[i] = 0.f; g1[i] = 0.f; v2[i] = 0.f; v1[i] = 0.f; } }
        } else {
            const bf16x8 a2 = *(const bf16x8*)(HH + (size_t)(m0 - 2) * FF2 + colg), a1 = *(const bf16x8*)(HH + (size_t)(m0 - 1) * FF2 + colg);
            const bf16x8 c2 = *(const bf16x8*)(HH + (size_t)(m0 - 2) * FF2 + colg + 128), c1 = *(const bf16x8*)(HH + (size_t)(m0 - 1) * FF2 + colg + 128);
#pragma unroll
            for (int i = 0; i < 8; ++i) { g2[i] = bf2f((bf16_t)a2[i]); g1[i] = bf2f((bf16_t)a1[i]); v2[i] = bf2f((bf16_t)c2[i]); v1[i] = bf2f((bf16_t)c1[i]); }
        }
        for (int r = 0; r < nrow; ++r) {
            const bf16x8 ag = *(const bf16x8*)(HH + (size_t)(m0 + r) * FF2 + colg), av = *(const bf16x8*)(HH + (size_t)(m0 + r) * FF2 + colg + 128);
            float o[8];
#pragma unroll
            for (int i = 0; i < 8; ++i) { const float hg = bf2f((bf16_t)ag[i]), hv = bf2f((bf16_t)av[i]);
                const float cg = bg[i] + wg[0][i] * g2[i] + wg[1][i] * g1[i] + wg[2][i] * hg, cv = bv[i] + wv[0][i] * v2[i] + wv[1][i] * v1[i] + wv[2][i] * hv;
                o[i] = cg / (1.0f + __expf(-cg)) * cv; g2[i] = g1[i]; g1[i] = hg; v2[i] = v1[i]; v1[i] = hv; }
            u32x4 w; w.x = cvt_pk_bf16(o[0], o[1]); w.y = cvt_pk_bf16(o[2], o[3]); w.z = cvt_pk_bf16(o[4], o[5]); w.w = cvt_pk_bf16(o[6], o[7]);
            *(u32x4*)(ACT + (size_t)(m0 + r) * FF + f0) = w;
        }
    }
}

__device__ __forceinline__ void kvpost_pass(const Args& a, const Frame& F) {
    unsigned char* ws = a.ws; const float* KV = (const float*)(ws + WS_KV); const float* knorm = (const float*)a.in[14];
    const int gw = F.vcu * NWAVES + F.wave, NGW = F.G * NWAVES, lane = F.lane;
    bf16_t* ACMP = (bf16_t*)(ws + WS_ACMP);
    for (int m = gw; m < MR; m += NGW) {
        const bool samp = m >= MP; const int b = samp ? (m - MP) >> 3 : m >> 12, t = samp ? (m - MP) & 7 : m & (SEQ - 1);
#pragma unroll 2
        for (int e = 0; e < 24; ++e) {
            const int br = e >> 3, v = (e >> 2) & 1, g = e & 3, bg = b * 4 + g;
            f32x2 raw = *(const f32x2*)(KV + (size_t)m * KVW + e * 128 + 2 * lane);
            if (br > 0 && v == 0) { const float ss = wave_sum(raw[0] * raw[0] + raw[1] * raw[1]); const float rstd = 1.0f / sqrtf(ss * (1.0f / 128.0f) + EPS);
                const f32x2 kn = *(const f32x2*)(knorm + br * 128 + 2 * lane); raw = raw * rstd * kn; }
            const unsigned pk = cvt_pk_bf16(raw[0], raw[1]); const size_t oe = (size_t)(v * 4 + g) * 128 + 2 * lane;
            if (br == 0) {
                if (!samp) { *(f32x2*)(a.out + O_CMPP + (size_t)m * 1024 + oe) = raw;
                    *(unsigned*)(ACMP + ((size_t)v * 2048 + (size_t)bg * 256 + (t >> 4)) * 2048 + (t & 15) * 128 + 2 * lane) = pk; }
                else *(f32x2*)(a.out + O_CMPS + (size_t)(m - MP) * 1024 + oe) = raw;
            } else if (br == 1) {
                if (!samp) { *(f32x2*)(a.out + O_SELP + (size_t)m * 1024 + oe) = raw;
                    *(unsigned*)((bf16_t*)(ws + (v ? WS_VSEL : WS_KSEL)) + ((size_t)bg * SEQ + t) * 128 + 2 * lane) = pk; }
                else { *(f32x2*)(a.out + O_SELS + (size_t)(m - MP) * 1024 + oe) = raw;
                    *(unsigned*)((bf16_t*)(ws + (v ? WS_VSELNS : WS_KSELNS)) + ((size_t)bg * 64 + t) * 128 + 2 * lane) = pk; }
            } else {
                if (!samp) { *(unsigned*)((bf16_t*)(ws + (v ? WS_VWIN : WS_KWIN)) + ((size_t)bg * SEQ + t) * 128 + 2 * lane) = pk;
                    if (t >= SEQ - 512) *(f32x2*)(a.out + O_WINP + ((size_t)b * 512 + (t - (SEQ - 512))) * 1024 + oe) = raw; }
                else { *(unsigned*)((bf16_t*)(ws + (v ? WS_VWINS : WS_KWINS)) + ((size_t)bg * 576 + 512 + t) * 128 + 2 * lane) = pk;
                    *(f32x2*)(a.out + O_WINS + ((size_t)b * 512 + 504 + t) * 1024 + oe) = raw; }
            }
        }
    }
}

__device__ __forceinline__ int crow(int r, int hi) { return (r & 3) + 8 * (r >> 2) + 4 * hi; }
__device__ __forceinline__ float gelu_tanh(float x) { const float u = 0.7978845608028654f * (x + 0.044715f * x * x * x); const float e = __expf(2.0f * u); const float th = 1.0f - 2.0f / (1.0f + e); return 0.5f * x * (1.0f + th); }
__device__ __forceinline__ void cmppost_pass(const Args& a, const Frame& F) {
    unsigned char* ws = a.ws; const float* P = (const float*)(ws + WS_PCMP); const bf16_t* W2T = (const bf16_t*)(ws + WS_W2T); const float* bias = (const float*)(ws + WS_CBIAS);
    const float* kn0 = (const float*)a.in[14];
    const int gw = F.vcu * NWAVES + F.wave, NGW = F.G * NWAVES, lane = F.lane, r32 = lane & 31, hi = lane >> 5;
    constexpr int NIT_P = 2 * 4 * 2 * 8, NIT = NIT_P + 8 * 4 * 2 * 32;
    for (int it = gw; it < NIT; it += NGW) {
        int sgb, g, v, ch, NC, pitch; size_t prow0; bf16_t* dst;
        if (it < NIT_P) { ch = it & 7; v = (it >> 3) & 1; g = (it >> 4) & 3; sgb = it >> 6; NC = NCP; pitch = 256; prow0 = (size_t)v * 2048 + (size_t)(sgb * 4 + g) * 256;
            dst = (bf16_t*)(ws + (v ? WS_VCP : WS_KCP)) + (size_t)(sgb * 4 + g) * 256 * 128; }
        else { const int q = it - NIT_P; ch = q & 31; v = (q >> 5) & 1; g = (q >> 6) & 3; sgb = q >> 8; NC = NCS; pitch = 1024; prow0 = (size_t)CMP_ROW_S0 + (size_t)v * 32768 + (size_t)(sgb * 4 + g) * 1024;
            dst = (bf16_t*)(ws + (v ? WS_VCS : WS_KCS)) + (size_t)(sgb * 4 + g) * 1024 * 128; }
        const int i = ch * 32 + r32; const bool iv = i < NC;
        bf16x8 af[8];
#pragma unroll
        for (int ks = 0; ks < 8; ++ks) { const int h0 = ks * 16 + hi * 8; float hv[8];
            if (iv) { const f32x4 p0 = *(const f32x4*)(P + (prow0 + i) * 256 + h0), p1 = *(const f32x4*)(P + (prow0 + i) * 256 + h0 + 4);
                const f32x4 q0 = *(const f32x4*)(P + (prow0 + i + 1) * 256 + 128 + h0), q1 = *(const f32x4*)(P + (prow0 + i + 1) * 256 + 128 + h0 + 4);
                const f32x4 b0 = *(const f32x4*)(bias + v * 128 + h0), b1 = *(const f32x4*)(bias + v * 128 + h0 + 4);
#pragma unroll
                for (int e = 0; e < 4; ++e) { hv[e] = gelu_tanh(p0[e] + q0[e] + b0[e]); hv[4 + e] = gelu_tanh(p1[e] + q1[e] + b1[e]); } }
            else {
#pragma unroll
                for (int e = 0; e < 8; ++e) hv[e] = 0.f; }
            u32x4 w; w.x = cvt_pk_bf16(hv[0], hv[1]); w.y = cvt_pk_bf16(hv[2], hv[3]); w.z = cvt_pk_bf16(hv[4], hv[5]); w.w = cvt_pk_bf16(hv[6], hv[7]); af[ks] = __builtin_bit_cast(bf16x8, w); }
        f32x16 o[4];
#pragma unroll
        for (int d0 = 0; d0 < 4; ++d0) { o[d0] = (f32x16){};
#pragma unroll
            for (int ks = 0; ks < 8; ++ks) { const bf16x8 bfr = *(const bf16x8*)(W2T + (size_t)v * 128 * 128 + (size_t)(32 * d0 + r32) * 128 + ks * 16 + hi * 8);
                o[d0] = __builtin_amdgcn_mfma_f32_32x32x16_bf16(af[ks], bfr, o[d0], 0, 0, 0); } }
#pragma unroll
        for (int r = 0; r < 16; ++r) {
            float sc = 1.0f;
            if (v == 0) { float ss = o[0][r] * o[0][r] + o[1][r] * o[1][r] + o[2][r] * o[2][r] + o[3][r] * o[3][r];
                ss += __shfl_xor(ss, 1); ss += __shfl_xor(ss, 2); ss += __shfl_xor(ss, 4); ss += __shfl_xor(ss, 8); ss += __shfl_xor(ss, 16);
                sc = 1.0f / sqrtf(ss * (1.0f / 128.0f) + EPS); }
            const int ir = ch * 32 + crow(r, hi);
            if (ir < NC) {
#pragma unroll
                for (int d0 = 0; d0 < 4; ++d0) { const int d = 32 * d0 + r32; const float val = v == 0 ? o[d0][r] * sc * kn0[d] : o[d0][r];
                    dst[(size_t)ir * 128 + d] = (bf16_t)(cvt_pk_bf16(val, 0.f) & 0xffffu); } }
        }
    }
}

namespace nsa {
#define KSWZ(row, colB) ((row) * 256 + ((colB) ^ (((row) & 7) << 4)))
constexpr float LOG2E = 1.4426950408889634f;
constexpr int L_K = 0, L_V = 16384, L_PQ = 32768, L_SELM = 98304, L_WUN = L_SELM + 64 * 5 * 8, L_WSF = L_WUN + 8 * 5 * 8, L_END = L_WSF + 8 * 64 * 4;
static_assert(L_END <= RING_BYTES, "attention LDS");
__device__ __forceinline__ int v_st(int k, int c) { const int kk = (k & ~0xC) | ((k & 4) << 1) | ((k & 8) >> 1); return ((kk >> 3) * 4 + (c >> 5)) * 512 + ((kk & 7) * 32 + (c & 31)) * 2; }
__device__ __forceinline__ int v_rd_base(int lane) { return ((lane & 3) << 3) | (((lane >> 2) & 3) << 6) | (((lane >> 4) & 1) << 5) | (((lane >> 5) & 1) << 8); }
constexpr int v_rd_off(int d0, int ks, int half) { return d0 * 512 + ks * 4096 + half * 2048; }
template <int OFF> __device__ __forceinline__ s16x4 tr_read(int vb) { s16x4 r; asm volatile("ds_read_b64_tr_b16 %0, %1 offset:%2" : "=&v"(r) : "v"(vb), "i"(OFF) : "memory"); return r; }
template <int D0> __device__ __forceinline__ void pv_one(f32x16& od, int vb, bf16x8 pa0, bf16x8 pa1, bf16x8 pa2, bf16x8 pa3) {
    const s16x4 l0 = tr_read<v_rd_off(D0, 0, 0)>(vb), h0 = tr_read<v_rd_off(D0, 0, 1)>(vb), l1 = tr_read<v_rd_off(D0, 1, 0)>(vb), h1 = tr_read<v_rd_off(D0, 1, 1)>(vb);
    const s16x4 l2 = tr_read<v_rd_off(D0, 2, 0)>(vb), h2 = tr_read<v_rd_off(D0, 2, 1)>(vb), l3 = tr_read<v_rd_off(D0, 3, 0)>(vb), h3 = tr_read<v_rd_off(D0, 3, 1)>(vb);
    asm volatile("s_waitcnt lgkmcnt(0)" ::: "memory"); SBAR();
#define PK(L, H) (bf16x8){L[0], L[1], L[2], L[3], H[0], H[1], H[2], H[3]}
    od = __builtin_amdgcn_mfma_f32_32x32x16_bf16(pa0, PK(l0, h0), od, 0, 0, 0);
    od = __builtin_amdgcn_mfma_f32_32x32x16_bf16(pa1, PK(l1, h1), od, 0, 0, 0);
    od = __builtin_amdgcn_mfma_f32_32x32x16_bf16(pa2, PK(l2, h2), od, 0, 0, 0);
    od = __builtin_amdgcn_mfma_f32_32x32x16_bf16(pa3, PK(l3, h3), od, 0, 0, 0);
#undef PK
}
__device__ __forceinline__ void pv_d0(f32x16* o, int vb, bf16x8 pa0, bf16x8 pa1, bf16x8 pa2, bf16x8 pa3) {
    pv_one<0>(o[0], vb, pa0, pa1, pa2, pa3); pv_one<1>(o[1], vb, pa0, pa1, pa2, pa3); pv_one<2>(o[2], vb, pa0, pa1, pa2, pa3); pv_one<3>(o[3], vb, pa0, pa1, pa2, pa3);
}
__device__ __forceinline__ void qkt(f32x16& p0, f32x16& p1, const LAS unsigned char* Ks, const bf16x8* qr, int r32, int hi) {
    p0 = (f32x16){}; p1 = (f32x16){};
#pragma unroll
    for (int d0 = 0; d0 < 8; ++d0) { const int cb = (d0 * 16 + hi * 8) * 2;
        const bf16x8 b0 = *(const LAS bf16x8*)(Ks + KSWZ(r32, cb)); const bf16x8 b1 = *(const LAS bf16x8*)(Ks + KSWZ(32 + r32, cb));
        p0 = __builtin_amdgcn_mfma_f32_32x32x16_bf16(b0, qr[d0], p0, 0, 0, 0);
        p1 = __builtin_amdgcn_mfma_f32_32x32x16_bf16(b1, qr[d0], p1, 0, 0, 0); }
}
__device__ __forceinline__ void p_to_frags(const f32x16& p0, const f32x16& p1, bf16x8& pa0, bf16x8& pa1, bf16x8& pa2, bf16x8& pa3) {
#define PK4(P, BASE, OUT) do { unsigned a0 = cvt_pk_bf16(P[BASE + 0], P[BASE + 1]), a1 = cvt_pk_bf16(P[BASE + 2], P[BASE + 3]);   \
    unsigned b0 = cvt_pk_bf16(P[BASE + 4], P[BASE + 5]), b1 = cvt_pk_bf16(P[BASE + 6], P[BASE + 7]);                              \
    auto r0 = __builtin_amdgcn_permlane32_swap(a0, b0, false, false); auto r1 = __builtin_amdgcn_permlane32_swap(a1, b1, false, false); \
    u32x4 w = {r0[0], r1[0], r0[1], r1[1]}; OUT = __builtin_bit_cast(bf16x8, w); } while (0)
    PK4(p0, 0, pa0); PK4(p0, 8, pa1); PK4(p1, 0, pa2); PK4(p1, 8, pa3);
#undef PK4
}
__device__ __forceinline__ float half_swap_max(float v) { auto rr = __builtin_amdgcn_permlane32_swap(__float_as_uint(v), __float_as_uint(v), false, false); return fmaxf(__uint_as_float(rr[0]), __uint_as_float(rr[1])); }
__device__ __forceinline__ float half_swap_sum(float v) { auto rr = __builtin_amdgcn_permlane32_swap(__float_as_uint(v), __float_as_uint(v), false, false); return __uint_as_float(rr[0]) + __uint_as_float(rr[1]); }

__device__ __forceinline__ void stage_bf16(LAS unsigned char* lds, const bf16_t* kp, const bf16_t* vp, bool with_v, int tid_in) {
    int tid = tid_in; asm volatile("" : "+v"(tid));
    const int sr = tid >> 4, sc = (tid & 15) * 8; const unsigned o0 = (unsigned)(sr * 128 + sc) * 2u, o1 = o0 + 32u * 128u * 2u;
    const bf16x8 k0 = *(const bf16x8*)((const char*)kp + o0), k1 = *(const bf16x8*)((const char*)kp + o1);
    bf16x8 v0, v1;
    if (with_v) { v0 = *(const bf16x8*)((const char*)vp + o0); v1 = *(const bf16x8*)((const char*)vp + o1); }
    *(LAS bf16x8*)(lds + L_K + KSWZ(sr, sc * 2)) = k0; *(LAS bf16x8*)(lds + L_K + KSWZ(32 + sr, sc * 2)) = k1;
    if (with_v) { *(LAS bf16x8*)(lds + L_V + v_st(sr, sc)) = v0; *(LAS bf16x8*)(lds + L_V + v_st(32 + sr, sc)) = v1; }
}
__device__ __forceinline__ bf16x8 cvt8(const float* p) { const f32x4 a = *(const f32x4*)p, b = *(const f32x4*)(p + 4);
    u32x4 w; w.x = cvt_pk_bf16(a[0], a[1]); w.y = cvt_pk_bf16(a[2], a[3]); w.z = cvt_pk_bf16(b[0], b[1]); w.w = cvt_pk_bf16(b[2], b[3]); return __builtin_bit_cast(bf16x8, w); }
__device__ __forceinline__ void stage_f32(LAS unsigned char* lds, const float* kp, int tid_in) {
    int tid = tid_in; asm volatile("" : "+v"(tid));
    const int sr = tid >> 4, sc = (tid & 15) * 8; const unsigned o0 = (unsigned)(sr * 1024 + sc), o1 = o0 + 32u * 1024u;
    { const bf16x8 k0 = cvt8(kp + o0), k1 = cvt8(kp + o1);
      *(LAS bf16x8*)(lds + L_K + KSWZ(sr, sc * 2)) = k0; *(LAS bf16x8*)(lds + L_K + KSWZ(32 + sr, sc * 2)) = k1; }
    { const bf16x8 v0 = cvt8(kp + o0 + 512), v1 = cvt8(kp + o1 + 512);
      *(LAS bf16x8*)(lds + L_V + v_st(sr, sc)) = v0; *(LAS bf16x8*)(lds + L_V + v_st(32 + sr, sc)) = v1; }
}

__device__ __forceinline__ void mask_tile(f32x16& p0, f32x16& p1, int tpos, int pos0, int pstride, int dmax, bool rowok, float slope2, int hi) {
    const float NEG = -INFINITY;
#pragma unroll
    for (int r = 0; r < 16; ++r) { const int kk = (r & 3) + 8 * (r >> 2) + 4 * hi;
        const int d0 = tpos - (pos0 + pstride * kk), d1 = d0 - 32 * pstride;
        p0[r] = (rowok && d0 >= 0 && d0 < dmax) ? p0[r] - slope2 * (float)d0 : NEG;
        p1[r] = (rowok && d1 >= 0 && d1 < dmax) ? p1[r] - slope2 * (float)d1 : NEG; }
}
__device__ __forceinline__ void softmax_pv(f32x16& p0, f32x16& p1, float& m_reg, float& l_reg, f32x16* o, int vb, LAS float* wsf, int r32, int hi) {
    float pmax = p0[0];
#pragma unroll
    for (int r = 1; r < 16; ++r) pmax = fmaxf(pmax, p0[r]);
#pragma unroll
    for (int r = 0; r < 16; ++r) pmax = fmaxf(pmax, p1[r]);
    pmax = half_swap_max(pmax);
    const float mn = fmaxf(m_reg, pmax); const float alpha = __builtin_amdgcn_exp2f(m_reg - mn); m_reg = mn;
    float ps = 0.f;
#pragma unroll
    for (int r = 0; r < 16; ++r) { p0[r] = __builtin_amdgcn_exp2f(p0[r] - mn); p1[r] = __builtin_amdgcn_exp2f(p1[r] - mn); ps += p0[r] + p1[r]; }
    ps = half_swap_sum(ps);
    l_reg = l_reg * alpha + ps;
    if (__any(alpha < 1.f)) { if (hi == 0) wsf[r32] = alpha; LDS_WAIT();
#pragma unroll
        for (int r = 0; r < 16; ++r) { const float al = wsf[crow(r, hi)];
#pragma unroll
            for (int d = 0; d < 4; ++d) o[d][r] *= al; }
        LDS_WAIT(); }
    bf16x8 pa0, pa1, pa2, pa3; p_to_frags(p0, p1, pa0, pa1, pa2, pa3);
    pv_d0(o, vb, pa0, pa1, pa2, pa3);
}
template <int MODE>
__device__ __forceinline__ void flush_branch(const f32x16* o, float f, float* OF, bf16_t* OB, int mbase, int g, int nq, int wid, LAS float* wsf, int r32, int hi) {
    LDS_WAIT(); if (hi == 0) wsf[r32] = f; LDS_WAIT();
#pragma unroll
    for (int r = 0; r < 16; ++r) { const int rr = crow(r, hi), hr = rr >> 3, qrow = wid * 8 + (rr & 7); const float fr = wsf[rr];
        if (qrow < nq) { const size_t base = (size_t)(mbase + qrow) * D + (g * 4 + hr) * 128 + r32;
#pragma unroll
            for (int d0 = 0; d0 < 4; ++d0) { float v = fr * o[d0][r];
                if (MODE > 0) v += __hip_atomic_load(OF + base + 32 * d0, __ATOMIC_RELAXED, __HIP_MEMORY_SCOPE_AGENT);
                if (MODE < 2) OF[base + 32 * d0] = v; else OB[base + 32 * d0] = (bf16_t)(cvt_pk_bf16(v, 0.f) & 0xffffu); } } }
    LDS_WAIT();
}

__device__ __forceinline__ void attn_unit(const Args& a, const Frame& F, int lj, bool samp, int b, int g, int qt) {
    unsigned char* ws = a.ws; LAS unsigned char* lds = F.lds;
    const int tid = F.tid, wid = F.wave, lane = F.lane, r32 = lane & 31, hi = lane >> 5;
    const int head = r32 >> 3, qi = r32 & 7, qq = wid * 8 + qi, nq = samp ? 8 : 64, bg = b * 4 + g;
    const bool rowok = qq < nq; const bool wactive = samp ? (wid == 0) : true;
    const int t0 = samp ? PAST : qt * 64, tpos = t0 + qq;
    const int mbase = samp ? MP + b * 8 : b * SEQ + qt * 64;
    const int mrow = mbase + (rowok ? qq : 0);
    const int hg = g * 4 + head;
    const float slope2 = exp2f(-0.5f * (float)(hg + 1)) * LOG2E;
    LAS float* wsf = (LAS float*)(lds + L_WSF) + wid * 64;
    LAS float* Pq = (LAS float*)(lds + L_PQ); const int pq_pitch = samp ? 1024 : 256;
    LAS u64* selm = (LAS u64*)(lds + L_SELM); LAS u64* wun = (LAS u64*)(lds + L_WUN);
    const int vb = (int)(uintptr_t)(lds + L_V) + v_rd_base(lane);
    const float* QG = (const float*)(ws + WS_QG);
    bf16x8 qr[8];
    { const float* qp = QG + (size_t)mrow * QGP + hg * 128 + hi * 8; const float* qn = (const float*)a.in[19] + lj * 128 + hi * 8;
      f32x4 qa[8][2]; float ss = 0.f;
#pragma unroll
      for (int d0 = 0; d0 < 8; ++d0) { qa[d0][0] = *(const f32x4*)(qp + d0 * 16); qa[d0][1] = *(const f32x4*)(qp + d0 * 16 + 4);
#pragma unroll
          for (int e = 0; e < 4; ++e) ss += qa[d0][0][e] * qa[d0][0][e] + qa[d0][1][e] * qa[d0][1][e]; }
      ss = half_swap_sum(ss);
      const float sc = (1.0f / sqrtf(ss * (1.0f / 128.0f) + EPS)) * 0.08838834764831845f * LOG2E;
#pragma unroll
      for (int d0 = 0; d0 < 8; ++d0) { const f32x4 n0 = *(const f32x4*)(qn + d0 * 16), n1 = *(const f32x4*)(qn + d0 * 16 + 4); const f32x4 x0 = qa[d0][0] * n0 * sc, x1 = qa[d0][1] * n1 * sc;
          u32x4 w; w.x = cvt_pk_bf16(x0[0], x0[1]); w.y = cvt_pk_bf16(x0[2], x0[3]); w.z = cvt_pk_bf16(x1[0], x1[1]); w.w = cvt_pk_bf16(x1[2], x1[3]); qr[d0] = __builtin_bit_cast(bf16x8, w); } }
    float gate[3];
#pragma unroll
    for (int br = 0; br < 3; ++br) { const float x = QG[(size_t)mrow * QGP + 2048 + hg * 3 + br]; gate[br] = 1.0f / (1.0f + __expf(-x)); }

    f32x16 o[4]; float* OF = (float*)(ws + WS_OF32); bf16_t* OBp = (bf16_t*)(ws + WS_OB);
    const int ncv = samp ? NCS : (4 * qt + 3 < NCP ? 4 * qt + 3 : NCP); const int ntc = (ncv + 63) >> 6;
    const bf16_t* KC = (const bf16_t*)(ws + (samp ? WS_KCS : WS_KCP)) + (size_t)bg * (samp ? 1024 : 256) * 128;
    const bf16_t* VC = (const bf16_t*)(ws + (samp ? WS_VCS : WS_VCP)) + (size_t)bg * (samp ? 1024 : 256) * 128;
    float m_c = -1e30f, l_c = 0.f;
    for (int tl = 0; tl < ntc; ++tl) {
        __syncthreads();
        stage_bf16(lds, KC + (size_t)tl * 64 * 128, nullptr, false, tid);
        __syncthreads();
        if (wactive) { f32x16 p0, p1; qkt(p0, p1, lds + L_K, qr, r32, hi);
            mask_tile(p0, p1, tpos, 16 * 64 * tl + 31, 16, 1 << 30, rowok, slope2, hi);
            float pmax = p0[0];
#pragma unroll
            for (int r = 1; r < 16; ++r) pmax = fmaxf(pmax, p0[r]);
#pragma unroll
            for (int r = 0; r < 16; ++r) pmax = fmaxf(pmax, p1[r]);
            pmax = half_swap_max(pmax);
            const float mn = fmaxf(m_c, pmax); float ps = 0.f;
#pragma unroll
            for (int r = 0; r < 16; ++r) ps += __builtin_amdgcn_exp2f(p0[r] - mn) + __builtin_amdgcn_exp2f(p1[r] - mn);
            ps = half_swap_sum(ps);
            l_c = l_c * __builtin_amdgcn_exp2f(m_c - mn) + ps; m_c = mn; }
    }
#pragma unroll
    for (int d = 0; d < 4; ++d) o[d] = (f32x16){};
    const float inv_c = l_c > 0.f ? 1.0f / l_c : 0.f;
    for (int tl = 0; tl < ntc; ++tl) {
        __syncthreads();
        stage_bf16(lds, KC + (size_t)tl * 64 * 128, VC + (size_t)tl * 64 * 128, true, tid);
        __syncthreads();
        if (wactive) { f32x16 p0, p1; qkt(p0, p1, lds + L_K, qr, r32, hi);
            mask_tile(p0, p1, tpos, 16 * 64 * tl + 31, 16, 1 << 30, rowok, slope2, hi);
#pragma unroll
            for (int r = 0; r < 16; ++r) { p0[r] = __builtin_amdgcn_exp2f(p0[r] - m_c) * inv_c; p1[r] = __builtin_amdgcn_exp2f(p1[r] - m_c) * inv_c; }
#pragma unroll
            for (int r = 0; r < 16; ++r) { float s0 = p0[r], s1 = p1[r]; s0 += __shfl_xor(s0, 8); s0 += __shfl_xor(s0, 16); s1 += __shfl_xor(s1, 8); s1 += __shfl_xor(s1, 16);
                if (head == 0 && rowok) { const int kk = crow(r, hi); Pq[qq * pq_pitch + tl * 64 + kk] = s0; Pq[qq * pq_pitch + tl * 64 + 32 + kk] = s1; } }
            bf16x8 pa0, pa1, pa2, pa3; p_to_frags(p0, p1, pa0, pa1, pa2, pa3);
            pv_d0(o, vb, pa0, pa1, pa2, pa3); }
    }
    if (wactive) flush_branch<0>(o, gate[0], OF, OBp, mbase, g, nq, wid, wsf, r32, hi);
    __syncthreads();
    const int nw = samp ? 5 : 1, nb = samp ? 257 : 64, nproc = ntc * 64;
    u64 myun[5] = {0ull, 0ull, 0ull, 0ull, 0ull};
    if (wactive) {
        for (int q2 = 0; q2 < 8; ++q2) {
            const int qq2 = wid * 8 + q2, t2 = t0 + qq2, cur = t2 >> 6;
            unsigned key[5]; bool vld[5];
#pragma unroll
            for (int w = 0; w < 5; ++w) { key[w] = 0u; vld[w] = false;
                if (w < nw) { const int jb = lane + 64 * w; float imp = 0.f;
#pragma unroll
                    for (int e = -1; e < 4; ++e) { const int c = 4 * jb + e; if (c >= 0 && c < nproc && jb < nb) imp += Pq[qq2 * pq_pitch + c]; }
                    const bool forced = (jb == 0) || (jb == cur) || (jb == cur - 1); vld[w] = (jb < nb) && (64 * jb <= t2);
                    const float val = vld[w] ? (forced ? imp + 1e4f : imp) : -1e30f; const unsigned bits = __float_as_uint(val);
                    key[w] = (jb < nb) ? ((bits & 0x80000000u) ? ~bits : (bits | 0x80000000u)) : 0u; } }
            unsigned T = 0u;
            for (int bit = 31; bit >= 0; --bit) { const unsigned cand = T | (1u << bit); int cnt = 0;
#pragma unroll
                for (int w = 0; w < 5; ++w) if (w < nw) cnt += __popcll(__ballot(key[w] >= cand));
                if (cnt >= 16) T = cand; }
            int ngt = 0;
#pragma unroll
            for (int w = 0; w < 5; ++w) if (w < nw) ngt += __popcll(__ballot(key[w] > T));
            int need = 16 - ngt, prev = 0;
#pragma unroll
            for (int w = 0; w < 5; ++w) if (w < nw) {
                const u64 eq = __ballot(key[w] == T); const int rank = prev + __popcll(eq & ((1ull << lane) - 1ull)); prev += __popcll(eq);
                const bool sel = (key[w] > T) || (key[w] == T && rank < need);
                const u64 mk = __ballot(sel && vld[w]);
                if (lane == 0) selm[qq2 * 5 + w] = mk;
                if (qq2 < nq) myun[w] |= mk; }
        }
    }
    if (lane == 0) {
#pragma unroll
        for (int w = 0; w < 5; ++w) if (w < nw) wun[wid * 5 + w] = myun[w]; }
    __syncthreads();
    float m_s = -1e30f, l_s = 0.f;
#pragma unroll
    for (int d = 0; d < 4; ++d) o[d] = (f32x16){};
    {
        const bf16_t* KS = (const bf16_t*)(ws + WS_KSEL) + (size_t)bg * SEQ * 128; const bf16_t* VS = (const bf16_t*)(ws + WS_VSEL) + (size_t)bg * SEQ * 128;
        const float* cache = (const float*)a.in[3]; const int* pt = (const int*)a.in[4] + b * 128;
        for (int w = 0; w < nw; ++w) {
            u64 U = 0ull;
#pragma unroll
            for (int x = 0; x < 8; ++x) U |= wun[x * 5 + w];
            unsigned ulo = __builtin_amdgcn_readfirstlane((unsigned)U), uhi = __builtin_amdgcn_readfirstlane((unsigned)(U >> 32));
            U = ((u64)uhi << 32) | ulo;
            const u64 mysel = rowok ? selm[qq * 5 + w] : 0ull;
            while (U) {
                const int bit = __builtin_ctzll(U); U &= U - 1ull; const int jb = 64 * w + bit;
                __syncthreads();
                if (!samp) stage_bf16(lds, KS + (size_t)jb * 64 * 128, VS + (size_t)jb * 64 * 128, true, tid);
                else if (jb < 256) stage_f32(lds, cache + ((size_t)pt[jb >> 1] * 128 + (jb & 1) * 64) * 1024 + g * 128, tid);
                else stage_bf16(lds, (const bf16_t*)(ws + WS_KSELNS) + (size_t)bg * 64 * 128, (const bf16_t*)(ws + WS_VSELNS) + (size_t)bg * 64 * 128, true, tid);
                __syncthreads();
                if (wactive) { f32x16 p0, p1; qkt(p0, p1, lds + L_K, qr, r32, hi);
                    mask_tile(p0, p1, tpos, 64 * jb, 1, 1 << 30, rowok && ((mysel >> bit) & 1ull), slope2, hi);
                    softmax_pv(p0, p1, m_s, l_s, o, vb, wsf, r32, hi); }
            }
        }
    }
    if (wactive) flush_branch<1>(o, l_s > 0.f ? gate[1] / l_s : 0.f, OF, OBp, mbase, g, nq, wid, wsf, r32, hi);
    float m_w = -1e30f, l_w = 0.f;
#pragma unroll
    for (int d = 0; d < 4; ++d) o[d] = (f32x16){};
    {
        const bf16_t* KW = samp ? (const bf16_t*)(ws + WS_KWINS) + (size_t)bg * 576 * 128 : (const bf16_t*)(ws + WS_KWIN) + (size_t)bg * SEQ * 128;
        const bf16_t* VW = samp ? (const bf16_t*)(ws + WS_VWINS) + (size_t)bg * 576 * 128 : (const bf16_t*)(ws + WS_VWIN) + (size_t)bg * SEQ * 128;
        const int jlo = samp ? 0 : (qt >= 8 ? qt - 8 : 0), jhi = samp ? 8 : qt, posb = samp ? PAST - 512 : 0;
        for (int jt = jlo; jt <= jhi; ++jt) {
            __syncthreads();
            stage_bf16(lds, KW + (size_t)jt * 64 * 128, VW + (size_t)jt * 64 * 128, true, tid);
            __syncthreads();
            if (wactive) { f32x16 p0, p1; qkt(p0, p1, lds + L_K, qr, r32, hi);
                mask_tile(p0, p1, tpos, posb + 64 * jt, 1, 512, rowok, slope2, hi);
                softmax_pv(p0, p1, m_w, l_w, o, vb, wsf, r32, hi); }
        }
    }
    if (wactive) flush_branch<2>(o, l_w > 0.f ? gate[2] / l_w : 0.f, OF, OBp, mbase, g, nq, wid, wsf, r32, hi);
    __syncthreads();
}

__device__ __forceinline__ void attn_phase(const Args& a, const Frame& F, int lj) {
    const int G = F.G;
    for (int rnd = 0; rnd * G < 512; ++rnd) {
        const int id = (rnd & 1) ? (rnd + 1) * G - 1 - F.vcu : rnd * G + F.vcu;
        if (id < 512) attn_unit(a, F, lj, false, (id >> 6) >> 2, (id >> 6) & 3, id & 63);
    }
    for (int us = F.vcu; us < 32; us += G) attn_unit(a, F, lj, true, us >> 2, us & 3, 0);
}
}

#ifndef PHMASK
#define PHMASK 0xFFFFFFFFu
#endif
#define PH(n) ((PHMASK >> (n)) & 1u)
__global__ void __launch_bounds__(NTHR, 2) mega_fwd(Args a) {
    extern __shared__ __attribute__((aligned(16))) unsigned char lds_raw[];
    Frame F; F.lds = (LAS unsigned char*)lds_raw; F.tid = threadIdx.x; F.lane = F.tid & 63; F.wave = __builtin_amdgcn_readfirstlane(F.tid >> 6);
    F.G = gridDim.x; { const int bx = blockIdx.x; F.vcu = (F.G % 8 == 0) ? (bx % 8) * (F.G / 8) + bx / 8 : bx; }
    unsigned char* ws = a.ws;
    volatile LAS unsigned* MISC = (volatile LAS unsigned*)(F.lds + MISC_OFF);
    for (int u = F.tid; u < (LDS_BYTES - LDSCTL_OFF) / 4; u += NTHR) ((LAS unsigned*)(F.lds + LDSCTL_OFF))[u] = 0u;
    __syncthreads();
    XcdBarrier bar = xcd_barrier_post((unsigned*)(ws + WS_CTL) + CW_BAR, MISC + 8);
    const int cblk = (int)blockIdx.x;
#define RELAUNDER() do { int t_ = threadIdx.x; asm volatile("" : "+v"(t_)); F.tid = t_; F.lane = t_ & 63; F.wave = __builtin_amdgcn_readfirstlane(t_ >> 6); asm volatile("" : "+s"(ws)); } while (0)

    RELAUNDER(); if (PH(0)) p0_prologue(a, F);
    xcd_barrier(bar);

    for (int l = 0; l < 4; ++l) {
        float* X = (float*)(ws + WS_X); bf16_t* XB = (bf16_t*)(ws + WS_XB);
        float* rowp_ffn = (float*)(ws + WS_ROWP + (size_t)(2 * l + 1) * ROWP_STRIDE);
        if (l < 2) {
            RELAUNDER(); if (PH(1)) pool_pass(a, F, l);
            xcd_barrier(bar);
            RELAUNDER(); if (PH(2)) { SchedMix S; S.o.init(NTM, 8, F.G, cblk);
              EpiResid E{X, X, XB, rowp_ffn, (const float*)a.in[11] + l * D, MR};
              pg8::gemm_phase<EpiResid, SchedMix, true>(F.lds, (const char*)(ws + WS_POOLED), (const char*)(ws + WS_WPOOL) + (size_t)l * 4 * 512 * 512 * 2, D, 512, 512, S, E); }
            xcd_barrier(bar);
        } else {
            const int lj = l - 2;
            RELAUNDER(); if (PH(3)) { SchedPlain S; S.o.init(NTM, lj == 0 ? 21 : 9, F.G, cblk); S.astep = (size_t)256 * D * 2; S.bstep = (size_t)256 * D * 2;
              const float* rowp_mix = (const float*)(ws + WS_ROWP + (size_t)(2 * l) * ROWP_STRIDE);
              EpiF32 E{rowp_mix, lj == 0 ? (float*)(ws + WS_KV) : (float*)(ws + WS_QG), lj == 0 ? KVW : QGP, lj == 0 ? 12 : 1000, (float*)(ws + WS_QG), QGP};
              pg8::gemm_phase<EpiF32, SchedPlain, true>(F.lds, (const char*)XB, (const char*)(ws + (lj == 0 ? WS_WKVQG : WS_WQG1)), D, D, D, S, E); }
            xcd_barrier(bar);
            if (lj == 0) {
                RELAUNDER(); if (PH(4)) kvpost_pass(a, F);
                xcd_barrier(bar);
                RELAUNDER(); if (PH(5)) { SchedCmp S; S.o.init(CMP_ROWS / 256, 1, F.G, cblk);
                  EpiF32 E{nullptr, (float*)(ws + WS_PCMP), 256, 1000, nullptr, 0};
                  pg8::gemm_phase<EpiF32, SchedCmp, true>(F.lds, (const char*)(ws + WS_ACMP), (const char*)(ws + WS_W1CAT), 2048, 2048, 2048, S, E); }
                xcd_barrier(bar);
                RELAUNDER(); if (PH(6)) cmppost_pass(a, F);
                xcd_barrier(bar);
            }
            RELAUNDER(); if (PH(7)) nsa::attn_phase(a, F, lj);
            xcd_barrier(bar);
            RELAUNDER(); if (PH(8)) { SchedPlain S; S.o.init(NTM, 8, F.G, cblk); S.astep = (size_t)256 * D * 2; S.bstep = (size_t)256 * D * 2;
              EpiResid E{X, X, XB, rowp_ffn, nullptr, MR};
              pg8::gemm_phase<EpiResid, SchedPlain, true>(F.lds, (const char*)(ws + WS_OB), (const char*)(ws + WS_WO) + (size_t)lj * D * D * 2, D, D, D, S, E); }
            xcd_barrier(bar);
        }
        RELAUNDER(); if (PH(9)) { SchedPlain S; S.o.init(NTM, 44, F.G, cblk); S.astep = (size_t)256 * D * 2; S.bstep = (size_t)256 * D * 2;
          EpiHH E{rowp_ffn, (bf16_t*)(ws + WS_HH), a.out + O_CONVP + (size_t)l * NBP * 2 * FF2, a.out + O_CONVS + (size_t)l * NBS * 2 * FF2};
          pg8::gemm_phase<EpiHH, SchedPlain, true>(F.lds, (const char*)XB, (const char*)(ws + WS_WIN) + (size_t)l * FF2 * D * 2, D, D, D, S, E); }
        xcd_barrier(bar);
        RELAUNDER(); if (PH(10)) convgate_pass(a, F, l);
        xcd_barrier(bar);
        RELAUNDER(); if (PH(11)) { SchedPlain S; S.o.init(NTM, 8, F.G, cblk); S.astep = (size_t)256 * FF * 2; S.bstep = (size_t)256 * FF * 2;
          float* rowp_next = l < 3 ? (float*)(ws + WS_ROWP + (size_t)(2 * l + 2) * ROWP_STRIDE) : nullptr;
          EpiResid E{X, l < 3 ? X : a.out, l < 3 ? XB : nullptr, rowp_next, nullptr, MR};
          pg8::gemm_phase<EpiResid, SchedPlain, true>(F.lds, (const char*)(ws + WS_ACT), (const char*)(ws + WS_WOUT) + (size_t)l * D * FF * 2, FF, FF, FF, S, E); }
        if (l < 3) xcd_barrier(bar);
    }
}

extern "C" void kernel_launch(void* const* d_in, const int* in_sizes, int n_in, void* d_out, int out_size, void* d_ws, size_t ws_size, hipStream_t stream) {
    static int grid = 0;
    if (grid == 0) {
        if (n_in != 25 || out_size != (int)O_END || ws_size < WS_END) { fprintf(stderr, "kernel_launch: unexpected shapes: n_in %d out %d ws %zu (need %zu)\n", n_in, out_size, ws_size, (size_t)WS_END); grid = -1; return; }
        int dev = 0, cus = 0, per_cu = 0;
        if (hipGetDevice(&dev) != hipSuccess || hipDeviceGetAttribute(&cus, hipDeviceAttributeMultiprocessorCount, dev) != hipSuccess) { grid = -1; return; }
        if (hipFuncSetAttribute((const void*)mega_fwd, hipFuncAttributeMaxDynamicSharedMemorySize, LDS_BYTES) != hipSuccess) { fprintf(stderr, "kernel_launch: hipFuncSetAttribute failed\n"); grid = -1; return; }
        if (hipOccupancyMaxActiveBlocksPerMultiprocessor(&per_cu, (const void*)mega_fwd, NTHR, LDS_BYTES) != hipSuccess || per_cu < 1) fprintf(stderr, "kernel_launch: occupancy query says %d\n", per_cu);
        (void)hipGetLastError();
        grid = cus;
    }
    if (grid < 0) return;
    (void)hipMemsetAsync((char*)d_ws + WS_CTL, 0, CTL_ZERO_BYTES, stream);
    Args a{};
    for (int i = 0; i < 25; ++i) a.in[i] = d_in[i];
    a.out = (float*)d_out; a.ws = (unsigned char*)d_ws;
    hipLaunchKernelGGL(mega_fwd, dim3(grid), dim3(NTHR), LDS_BYTES, stream, a);
    const hipError_t le = hipPeekAtLastError();
    if (le != hipSuccess) fprintf(stderr, "kernel_launch: launch failed: %s\n", hipGetErrorName(le));
}
```

```cpp
#include <hip/hip_runtime.h>
#include <cstdio>
#include <cstdint>

#define GAS __attribute__((address_space(1)))
#define LAS __attribute__((address_space(3)))
typedef unsigned short bf16_t;
typedef short bf16x8 __attribute__((ext_vector_type(8)));
typedef short s16x4 __attribute__((ext_vector_type(4)));
typedef float f32x2 __attribute__((ext_vector_type(2)));
typedef float f32x4 __attribute__((ext_vector_type(4)));
typedef float f32x8 __attribute__((ext_vector_type(8)));
typedef float f32x16 __attribute__((ext_vector_type(16)));
typedef unsigned u32x2 __attribute__((ext_vector_type(2)));
typedef unsigned u32x4 __attribute__((ext_vector_type(4)));
typedef unsigned long long u64;

constexpr int D = 2048, SEQ = 4096, NBP = 2, NBS = 8, TS = 8, PAST = 16384;
constexpr int MP = NBP * SEQ, MS = NBS * TS, MR = MP + MS, MPAD = 8448, NTM = MPAD / 256;
constexpr int FF = 5632, FF2 = 11264, NG = 4, HD = 128;
constexpr int KVW = 3072, QGW = 2096, QGP = 2304;
constexpr int NCP = 255, NCS = 1023;
constexpr float EPS = 1e-6f;
constexpr int NWAVES = 8, NTHR = 512;

constexpr size_t O_Y = 0, O_CMPP = 16908288, O_CMPS = 25296896, O_SELP = 25362432, O_SELS = 33751040, O_WINP = 33816576, O_WINS = 34865152,
                 O_POOLP = 39059456, O_POOLS = 39182336, O_CONVP = 39673856, O_CONVS = 39854080, O_END = 40574976;

constexpr size_t MiB = 1u << 20;
constexpr size_t WS_CTL = 0, CTL_ZERO_BYTES = 1 * MiB;
constexpr size_t WS_ROWP = 2 * MiB;
constexpr size_t ROWP_STRIDE = 2 * MiB;
constexpr size_t WS_WPOOL = 18 * MiB;
constexpr size_t WS_WIN = 22 * MiB;
constexpr size_t WS_WOUT = 198 * MiB;
constexpr size_t WS_WKVQG = 286 * MiB;
constexpr size_t WS_WQG1 = 307 * MiB;
constexpr size_t WS_WO = 316 * MiB;
constexpr size_t WS_W1CAT = 332 * MiB;
constexpr size_t WS_W2T = 334 * MiB;
constexpr size_t WS_CBIAS = 334 * MiB + 256 * 1024;
constexpr size_t WS_X = 335 * MiB;
constexpr size_t WS_XB = 401 * MiB;
constexpr size_t WS_POOLED = 434 * MiB;
constexpr size_t WS_HH = 467 * MiB;
constexpr size_t WS_ACT = 649 * MiB;
constexpr size_t WS_KV = 740 * MiB;
constexpr size_t WS_QG = 839 * MiB;
constexpr size_t WS_OB = 914 * MiB;
constexpr size_t WS_KSEL = 947 * MiB, WS_VSEL = 955 * MiB, WS_KWIN = 963 * MiB, WS_VWIN = 971 * MiB;
constexpr size_t WS_KCP = 979 * MiB, WS_VCP = 979 * MiB + 512 * 1024;
constexpr size_t WS_KCS = 980 * MiB, WS_VCS = 988 * MiB;
constexpr size_t WS_KWINS = 996 * MiB, WS_VWINS = 1001 * MiB;
constexpr size_t WS_KSELNS = 1006 * MiB, WS_VSELNS = 1006 * MiB + 512 * 1024;
constexpr size_t WS_ACMP = 1007 * MiB;
constexpr size_t WS_PCMP = 1279 * MiB;
constexpr size_t WS_OF32 = 1347 * MiB;
constexpr size_t WS_END = 1413 * MiB;
constexpr int CMP_ROWS = 69632, CMP_ROW_S0 = 4096;

constexpr int CW_TMO = 0, CW_BAR = 4096;

constexpr int RING_BYTES = 131072, LDSCTL_OFF = RING_BYTES, MISC_OFF = LDSCTL_OFF + 320, LDS_BYTES = 147456;

#define LDS_WAIT() asm volatile("s_waitcnt lgkmcnt(0)" ::: "memory")
#define VM_WAIT() asm volatile("s_waitcnt vmcnt(0)" ::: "memory")
#define SBAR() __builtin_amdgcn_sched_barrier(0)
__device__ __forceinline__ unsigned cvt_pk_bf16(float lo, float hi) { unsigned r; asm volatile("v_cvt_pk_bf16_f32 %0, %1, %2" : "=v"(r) : "v"(lo), "v"(hi)); return r; }
__device__ __forceinline__ float bf2f(bf16_t v) { return __uint_as_float((unsigned)v << 16); }
__device__ __forceinline__ float wave_sum(float v) {
#pragma unroll
    for (int o = 1; o < 64; o <<= 1) v += __shfl_xor(v, o);
    return v;
}

#define XB_TMO      128
#define XB_XCNT(j)  (256  + 64 * (j))
#define XB_XSUB(j)  (1280 + 64 * (j))
#define XB_XGEN(j)  (2304 + 64 * (j))
#define XB_TOP      3328
#define XB_TOPGEN   3392
#define XCD_BAR_WORDS 3456
#define XB_SPIN_CAP (1u << 18)
__device__ __forceinline__ unsigned xb_ld(unsigned* p)              { return __hip_atomic_load(p, __ATOMIC_RELAXED, __HIP_MEMORY_SCOPE_AGENT); }
__device__ __forceinline__ unsigned xb_add(unsigned* p, unsigned v) { return __hip_atomic_fetch_add(p, v, __ATOMIC_RELAXED, __HIP_MEMORY_SCOPE_AGENT); }
__device__ __forceinline__ unsigned xb_xcc_id() { return (unsigned)__builtin_amdgcn_s_getreg((3 << 11) | 20) & 0xFu; }
#define XB_SPIN(cond, bar) do { unsigned _sp = 0; while (cond) { __builtin_amdgcn_s_sleep(1); \
    if ((++_sp & 255u) == 0u) { if (xb_ld(&(bar)[XB_TMO])) break; if (_sp > XB_SPIN_CAP) { atomicAdd(&(bar)[XB_TMO], 1u); break; } } } } while (0)
struct XcdBarrier { unsigned* bar; unsigned x; volatile LAS unsigned* st; };
__device__ __forceinline__ XcdBarrier xcd_barrier_post(unsigned* bar, volatile LAS unsigned* st) {
    XcdBarrier b; b.bar = bar; b.x = xb_xcc_id(); b.st = st;
    if (threadIdx.x == 0) (void)xb_add(&bar[XB_XCNT(b.x)], 1u);
    return b;
}
__device__ __forceinline__ void xcd_barrier_complete(unsigned* bar, unsigned x, unsigned& nloc, unsigned& nx) {
    const unsigned G = gridDim.x * gridDim.y * gridDim.z;
    unsigned sum, cnt, mine, sp = 0u;
    for (;;) {
        sum = 0u; cnt = 0u; mine = 0u;
#pragma unroll
        for (unsigned j = 0; j < 16; ++j) { const unsigned c = xb_ld(&bar[XB_XCNT(j)]); sum += c; cnt += (c > 0u) ? 1u : 0u; mine = (j == x) ? c : mine; }
        if (sum == G) break;
        __builtin_amdgcn_s_sleep(1);
        if ((++sp & 255u) == 0u) { if (xb_ld(&bar[XB_TMO])) break; if (sp > XB_SPIN_CAP) { atomicAdd(&bar[XB_TMO], 1u); break; } }
    }
    nloc = mine > 0u ? mine : 1u; nx = cnt > 0u ? cnt : 1u;
}
__device__ __forceinline__ void xcd_barrier(const XcdBarrier& b) {
    asm volatile("s_waitcnt vmcnt(0)" ::: "memory");
    __syncthreads();
    if (threadIdx.x == 0) {
        unsigned* bar = b.bar; asm volatile("" : "+s"(bar));
        const unsigned bx_ = xb_xcc_id();
        __builtin_amdgcn_s_waitcnt(0);
        unsigned nloc = b.st[0], nx = b.st[1];
        if (nloc == 0u) { xcd_barrier_complete(bar, bx_, nloc, nx); b.st[0] = nloc; b.st[1] = nx; }
        const unsigned old = xb_add(&bar[XB_XSUB(bx_)], 1u);
        const unsigned gen = old / nloc;
        if (old + 1u == (gen + 1u) * nloc) {
            __builtin_amdgcn_fence(__ATOMIC_RELEASE, "agent");
            asm volatile("s_waitcnt vmcnt(0)" ::: "memory");
            const unsigned og = xb_add(&bar[XB_TOP], 1u);
            const unsigned tg = og / nx;
            if (og + 1u == (tg + 1u) * nx) xb_add(&bar[XB_TOPGEN], 1u);
            else XB_SPIN(xb_ld(&bar[XB_TOPGEN]) == tg, bar);
            __builtin_amdgcn_fence(__ATOMIC_ACQUIRE, "agent");
            xb_add(&bar[XB_XGEN(bx_)], 1u);
            asm volatile("s_waitcnt vmcnt(0)" ::: "memory");
        } else {
            XB_SPIN(xb_ld(&bar[XB_XGEN(bx_)]) == gen, bar);
            __builtin_amdgcn_fence(__ATOMIC_ACQUIRE, "agent");
            asm volatile("s_waitcnt vmcnt(0)" ::: "memory");
        }
    }
    __syncthreads();
}

namespace pg8 {
constexpr int BM = 256, BK = 64, HALF = 128, HTB = HALF * BK * 2, STAGE_BYTES = 8 * HTB, NXCD = 8, WGM = 8;
__host__ __device__ __forceinline__ int lds_byte(int r, int c) { const int st = (r >> 4) * 2 + (c >> 5), rr = r & 15, cc = c & 31, ob = rr * 64 + cc * 2; return st * 1024 + (ob ^ (((ob >> 9) & 1) << 5)); }
__host__ __device__ __forceinline__ void stage_rc(int b, int& R, int& C) { const int st = b / 1024, sb = b % 1024, swz = sb ^ (((sb >> 9) & 1) << 5); R = (st >> 1) * 16 + swz / 64; C = (st & 1) * 32 + (swz % 64) / 2; }
__host__ __device__ __forceinline__ int perm32(int rho) { const int n = rho >> 4, i = rho & 15; return 8 * (i >> 2) + 4 * n + (i & 3); }
struct Unit { int pm, pn; };
struct Order {
    int nM, nN, nwg, G, c;
    __device__ __forceinline__ void init(int nM_, int nN_, int G_, int c_) { nM = nM_; nN = nN_; nwg = nM * nN; G = G_; c = c_; }
    __device__ __forceinline__ bool next(int i, Unit& u) const {
        const long L = (long)i * G + c; if (L >= nwg) return false;
        int wgid = (int)L; { const int q = nwg / NXCD, r = nwg % NXCD, xcd = wgid % NXCD, off = wgid / NXCD; wgid = (xcd < r ? xcd * (q + 1) : r * (q + 1) + (xcd - r) * q) + off; }
        const int nig = WGM * nN, gid = wgid / nig, fm = gid * WGM, gsz = (nM - fm) < WGM ? (nM - fm) : WGM;
        u.pm = fm + ((wgid % nig) % gsz); u.pn = (wgid % nig) / gsz; return true;
    }
};
template <class Epi, class Sched, bool ALIGN_EPI>
__device__ __forceinline__ void gemm_phase(LAS unsigned char* lds, const char* Abase, const char* Bbase, int lda, int ldb, int K, const Sched& S, const Epi& E) {
    int tid = threadIdx.x; asm volatile("" : "+v"(tid));
    const int wid = __builtin_amdgcn_readfirstlane(tid >> 6), lane = tid & 63, wr = wid >> 2, wc = wid & 3, fr = lane & 15, fq = lane >> 4;
    const int nt = K / BK;
    unsigned voffA[2], voffB[2];
#pragma unroll
    for (int i = 0; i < 2; ++i) { int R, C; stage_rc(tid * 16 + i * 8192, R, C); const int Rb = Epi::PERM ? ((R & ~31) + perm32(R & 31)) : R;
        voffA[i] = (unsigned)(R * lda + C) * 2u; voffB[i] = (unsigned)(Rb * ldb + C) * 2u; }
    const size_t kstep = (size_t)(BK * 2);
    const size_t hstepA = (size_t)HALF * lda * 2, hstepB = (size_t)HALF * ldb * 2;
    const unsigned ldsw = (unsigned)wid * 1024u;
    const int aoff = lds_byte(wr * 64 + fr, fq * 8), boff = lds_byte(wc * 32 + fr, fq * 8);
#define PG8_SA(b, h) (((b) * 2 + (h)) * HTB)
#define PG8_SB(b, h) ((4 + (b) * 2 + (h)) * HTB)
#define PG8_STAGE(bufoff, gbase, voff) do { _Pragma("unroll") for (int _i = 0; _i < 2; ++_i) \
        __builtin_amdgcn_global_load_lds((const unsigned*)((const char*)(gbase) + (voff)[_i]), (LAS unsigned*)(lds + (bufoff) + ldsw + _i * 8192), 16, 0, 0); } while (0)
#define PG8_LDA(dst, b, h) do { _Pragma("unroll") for (int m = 0; m < 4; ++m) _Pragma("unroll") for (int k = 0; k < 2; ++k) dst[m][k] = *(const LAS bf16x8*)(lds + PG8_SA(b, h) + aoff + m * 2048 + k * 1024); } while (0)
#define PG8_LDB(dst, b, h) do { _Pragma("unroll") for (int n = 0; n < 2; ++n) _Pragma("unroll") for (int k = 0; k < 2; ++k) dst[n][k] = *(const LAS bf16x8*)(lds + PG8_SB(b, h) + boff + n * 2048 + k * 1024); } while (0)
#define PG8_MMA(ai, bj, At, Bt) do { __builtin_amdgcn_s_setprio(1); _Pragma("unroll") for (int m = 0; m < 4; ++m) _Pragma("unroll") for (int n = 0; n < 2; ++n) _Pragma("unroll") for (int k = 0; k < 2; ++k) \
        acc[ai][bj][m][n] = __builtin_amdgcn_mfma_f32_16x16x32_bf16(Bt[n][k], At[m][k], acc[ai][bj][m][n], 0, 0, 0); __builtin_amdgcn_s_setprio(0); } while (0)
#define PG8_WAIT_V(n) asm volatile("s_waitcnt vmcnt(" #n ")" ::: "memory")
#define PG8_WAIT_L(n) asm volatile("s_waitcnt lgkmcnt(" #n ")" ::: "memory")
#define PG8_BAR __builtin_amdgcn_s_barrier()
#define PG8_SCHED __builtin_amdgcn_sched_barrier(0)
    Unit cur, nxt; int ui = 0;
    if (!S.next(0, cur)) return;
    f32x4 acc[2][2][4][2];
#pragma unroll
    for (int a = 0; a < 2; ++a)
#pragma unroll
        for (int b = 0; b < 2; ++b)
#pragma unroll
            for (int m = 0; m < 4; ++m)
#pragma unroll
                for (int n = 0; n < 2; ++n) acc[a][b][m][n] = (f32x4){0.f, 0.f, 0.f, 0.f};
    bf16x8 At[4][2], B0[2][2], B1[2][2];
    const char* cA = Abase + S.aoff(cur); const char* cB = Bbase + S.boff(cur);
    PG8_STAGE(PG8_SB(0, 0), cB, voffB); PG8_STAGE(PG8_SB(0, 1), cB + hstepB, voffB); PG8_STAGE(PG8_SA(0, 0), cA, voffA); PG8_STAGE(PG8_SA(0, 1), cA + hstepA, voffA);
    if (wr == 1) PG8_BAR;
    PG8_WAIT_V(2); PG8_BAR;
    PG8_STAGE(PG8_SB(1, 0), cB + kstep, voffB); PG8_STAGE(PG8_SA(1, 0), cA + kstep, voffA); PG8_STAGE(PG8_SB(1, 1), cB + hstepB + kstep, voffB);
    PG8_WAIT_V(6); PG8_BAR;
    for (;;) {
        const bool has_next = S.next(ui + 1, nxt);
        const char* nA = has_next ? Abase + S.aoff(nxt) : cA; const char* nB = has_next ? Bbase + S.boff(nxt) : cB;
        for (int t = 0; t < nt; t += 2) {
            const bool last = (t == nt - 2);
            const char* a1 = cA + (size_t)(t + 1) * kstep;
            const char* a2 = last ? nA : cA + (size_t)(t + 2) * kstep; const char* b2 = last ? nB : cB + (size_t)(t + 2) * kstep;
            const char* a3 = a2 + kstep; const char* b3 = b2 + kstep;
            PG8_LDB(B0, 0, 0); PG8_LDB(B1, 0, 1); PG8_SCHED; PG8_LDA(At, 0, 0); PG8_STAGE(PG8_SA(1, 1), a1 + hstepA, voffA);
            PG8_WAIT_V(8); PG8_WAIT_L(0); PG8_BAR; PG8_MMA(0, 0, At, B0); PG8_MMA(0, 1, At, B1); PG8_BAR; PG8_SCHED;
            PG8_LDA(At, 0, 1); PG8_STAGE(PG8_SB(0, 0), b2, voffB); PG8_STAGE(PG8_SB(0, 1), b2 + hstepB, voffB); PG8_STAGE(PG8_SA(0, 0), a2, voffA);
            PG8_WAIT_V(8); PG8_WAIT_L(0); PG8_BAR; PG8_MMA(1, 0, At, B0); PG8_MMA(1, 1, At, B1); PG8_BAR; PG8_SCHED;
            PG8_LDB(B0, 1, 0); PG8_LDB(B1, 1, 1); PG8_SCHED; PG8_LDA(At, 1, 0); PG8_STAGE(PG8_SA(0, 1), a2 + hstepA, voffA);
            PG8_WAIT_V(8); PG8_WAIT_L(0); PG8_BAR; PG8_MMA(0, 0, At, B0); PG8_MMA(0, 1, At, B1); PG8_BAR; PG8_SCHED;
            PG8_LDA(At, 1, 1); PG8_STAGE(PG8_SB(1, 0), b3, voffB); PG8_STAGE(PG8_SB(1, 1), b3 + hstepB, voffB); PG8_STAGE(PG8_SA(1, 0), a3, voffA);
            PG8_WAIT_V(8); PG8_WAIT_L(0); PG8_BAR; PG8_MMA(1, 0, At, B0); PG8_MMA(1, 1, At, B1); PG8_BAR; PG8_SCHED;
        }
        if constexpr (ALIGN_EPI) { if (wr == 0) PG8_BAR; }
        { int fr_ = fr, fq_ = fq; asm volatile("" : "+v"(fr_), "+v"(fq_)); E(acc, cur, wr, wc, fr_, fq_); }
        if (!has_next) break;
#pragma unroll
        for (int a = 0; a < 2; ++a)
#pragma unroll
            for (int b = 0; b < 2; ++b)
#pragma unroll
                for (int m = 0; m < 4; ++m)
#pragma unroll
                    for (int n = 0; n < 2; ++n) acc[a][b][m][n] = (f32x4){0.f, 0.f, 0.f, 0.f};
        cur = nxt; cA = nA; cB = nB; ++ui;
        if constexpr (ALIGN_EPI) { if (wr == 1) PG8_BAR; }
    }
    PG8_WAIT_V(0);
    if constexpr (!ALIGN_EPI) { if (wr == 0) PG8_BAR; }
    PG8_BAR;
#undef PG8_SA
#undef PG8_SB
#undef PG8_STAGE
#undef PG8_LDA
#undef PG8_LDB
#undef PG8_MMA
#undef PG8_WAIT_V
#undef PG8_WAIT_L
#undef PG8_BAR
#undef PG8_SCHED
}
}
using pg8::Unit;

__device__ __forceinline__ float row_rstd(const float* rowp, int m) {
    const f32x4* p = (const f32x4*)(rowp + (size_t)m * 32); float s = 0.f;
#pragma unroll
    for (int i = 0; i < 8; ++i) { const f32x4 v = p[i]; s += (v[0] + v[1]) + (v[2] + v[3]); }
    return 1.0f / sqrtf(s * (1.0f / D) + EPS);
}

__device__ __forceinline__ float row_rstd4(const float* rowp, int m, int fq) {
    const f32x4* p = (const f32x4*)(rowp + (size_t)m * 32 + fq * 8); const f32x4 v0 = p[0], v1 = p[1];
    float s = ((v0[0] + v0[1]) + (v0[2] + v0[3])) + ((v1[0] + v1[1]) + (v1[2] + v1[3]));
    s += __shfl_xor(s, 16); s += __shfl_xor(s, 32);
    return 1.0f / sqrtf(s * (1.0f / D) + EPS);
}
struct SchedPlain {
    pg8::Order o; size_t astep, bstep;
    __device__ __forceinline__ bool next(int i, Unit& u) const { return o.next(i, u); }
    __device__ __forceinline__ size_t aoff(const Unit& u) const { return (size_t)u.pm * astep; }
    __device__ __forceinline__ size_t boff(const Unit& u) const { return (size_t)u.pn * bstep; }
};
struct SchedMix {
    pg8::Order o;
    __device__ __forceinline__ bool next(int i, Unit& u) const { return o.next(i, u); }
    __device__ __forceinline__ size_t aoff(const Unit& u) const { return ((size_t)u.pm * 256 * D + (size_t)(u.pn >> 1) * 512) * 2; }
    __device__ __forceinline__ size_t boff(const Unit& u) const { return ((size_t)(u.pn >> 1) * 512 * 512 + (size_t)(u.pn & 1) * 256 * 512) * 2; }
};
struct SchedCmp {
    pg8::Order o;
    __device__ __forceinline__ bool next(int i, Unit& u) const { return o.next(i, u); }
    __device__ __forceinline__ size_t aoff(const Unit& u) const { return (size_t)u.pm * 256 * 2048 * 2; }
    __device__ __forceinline__ size_t boff(const Unit& u) const { const int v = (u.pm < 8) ? 0 : (u.pm < 16) ? 1 : (u.pm < 144) ? 0 : 1; return (size_t)v * 256 * 2048 * 2; }
};

struct EpiResid {
    static constexpr bool PERM = false;
    const float* xin; float* xout; bf16_t* xb; float* rowp; const float* colscale; int mlimit;
    __device__ __forceinline__ void operator()(const f32x4 (&acc)[2][2][4][2], const Unit& u, int wr, int wc, int fr, int fq) const {
        const int col0 = u.pn * 256 + wc * 32 + 4 * fq;
        f32x4 cs[2][2];
#pragma unroll
        for (int bj = 0; bj < 2; ++bj)
#pragma unroll
            for (int n = 0; n < 2; ++n) cs[bj][n] = colscale ? *(const f32x4*)(colscale + col0 + bj * 128 + n * 16) : (f32x4){1.f, 1.f, 1.f, 1.f};
#pragma unroll
        for (int ai = 0; ai < 2; ++ai)
#pragma unroll
            for (int m = 0; m < 4; ++m) {
                const int row = u.pm * 256 + ai * 128 + wr * 64 + m * 16 + fr; const size_t off = (size_t)row * D + col0; float ss = 0.f;
                const bool ok = row < mlimit;
#pragma unroll
                for (int bj = 0; bj < 2; ++bj)
#pragma unroll
                    for (int n = 0; n < 2; ++n) {
                        f32x4 b = ok ? *(const f32x4*)(xin + off + bj * 128 + n * 16) : (f32x4){0.f, 0.f, 0.f, 0.f};
                        const f32x4 v = b + acc[ai][bj][m][n] * cs[bj][n];
                        ss += (v[0] * v[0] + v[1] * v[1]) + (v[2] * v[2] + v[3] * v[3]);
                        if (ok) { *(f32x4*)(xout + off + bj * 128 + n * 16) = v;
                            if (xb) { u32x2 w; w.x = cvt_pk_bf16(v[0], v[1]); w.y = cvt_pk_bf16(v[2], v[3]); *(u32x2*)(xb + off + bj * 128 + n * 16) = w; } }
                    }
                ss += __shfl_xor(ss, 16); ss += __shfl_xor(ss, 32);
                if (rowp && fq == 0 && ok) rowp[(size_t)row * 32 + u.pn * 4 + wc] = ss;
                if (m & 1) asm volatile("" ::: "memory");
            }
    }
};
struct EpiF32 {
    static constexpr bool PERM = false;
    const float* rowp; float* out; int ldo; int split; float* out2; int ldo2;
    __device__ __forceinline__ void operator()(const f32x4 (&acc)[2][2][4][2], const Unit& u, int wr, int wc, int fr, int fq) const {
        float* o = out; int ld = ldo; int pn = u.pn; if (pn >= split) { o = out2; ld = ldo2; pn -= split; }
        const int col0 = pn * 256 + wc * 32 + 4 * fq;
#pragma unroll
        for (int ai = 0; ai < 2; ++ai)
#pragma unroll
            for (int m = 0; m < 4; ++m) {
                const int row = u.pm * 256 + ai * 128 + wr * 64 + m * 16 + fr; const float rs = rowp ? row_rstd4(rowp, row, fq) : 1.0f; const size_t off = (size_t)row * ld + col0;
#pragma unroll
                for (int bj = 0; bj < 2; ++bj)
#pragma unroll
                    for (int n = 0; n < 2; ++n) *(f32x4*)(o + off + bj * 128 + n * 16) = acc[ai][bj][m][n] * rs;
            }
    }
};
struct EpiHH {
    static constexpr bool PERM = true;
    const float* rowp; bf16_t* hh; float* convp; float* convs;
    __device__ __forceinline__ void operator()(const f32x4 (&acc)[2][2][4][2], const Unit& u, int wr, int wc, int fr, int fq) const {
        const int colt = wc * 32 + 8 * fq;
#pragma unroll
        for (int ai = 0; ai < 2; ++ai)
#pragma unroll
            for (int m = 0; m < 4; ++m) {
                const int trow = ai * 128 + wr * 64 + m * 16 + fr, row = u.pm * 256 + trow; const float rs = row_rstd4(rowp, row, fq);
                bf16_t* rowptr = hh + (size_t)row * FF2 + u.pn * 256 + colt;
                float* cdst = nullptr;
                if (u.pm == 32) { if (trow < 64 && (trow & 7) >= 6) cdst = convs + ((size_t)(trow >> 3) * 2 + ((trow & 7) - 6)) * FF2; }
                else if ((u.pm & 15) == 15 && trow >= 254) cdst = convp + ((size_t)(u.pm >> 4) * 2 + (trow - 254)) * FF2;
#pragma unroll
                for (int bj = 0; bj < 2; ++bj) {
                    const f32x4 v0 = acc[ai][bj][m][0] * rs, v1 = acc[ai][bj][m][1] * rs;
                    u32x4 w; w.x = cvt_pk_bf16(v0[0], v0[1]); w.y = cvt_pk_bf16(v0[2], v0[3]); w.z = cvt_pk_bf16(v1[0], v1[1]); w.w = cvt_pk_bf16(v1[2], v1[3]);
                    *(u32x4*)(rowptr + bj * 128) = w;
                    if (cdst) { float* c = cdst + bj * FF + u.pn * 128 + colt; *(f32x4*)c = v0; *(f32x4*)(c + 4) = v1; }
                }
            }
    }
};


__device__ __forceinline__ void mini_resid(LAS unsigned char* lds, int tid_in, const bf16_t* A, int lda, const bf16_t* Bt, int ldb, int K, int nb,
                                           const float* xin, float* xout, bf16_t* xb, float* rowp, const float* colscale, int row0) {
    int tid = tid_in; asm volatile("" : "+v"(tid));
    const int wid = __builtin_amdgcn_readfirstlane(tid >> 6), lane = tid & 63, fr = lane & 15, fq = lane >> 4;
    const int kw = K >> 3, kbeg = wid * kw;
    f32x4 acc[4][4];
#pragma unroll
    for (int i = 0; i < 4; ++i)
#pragma unroll
        for (int j = 0; j < 4; ++j) acc[i][j] = (f32x4){0.f, 0.f, 0.f, 0.f};
    const bf16_t* ap = A + (size_t)fr * lda + kbeg + fq * 8; const bf16_t* bp = Bt + (size_t)fr * ldb + kbeg + fq * 8;
    for (int k = 0; k < kw; k += 32) {
        bf16x8 af[4], bf[4];
#pragma unroll
        for (int i = 0; i < 4; ++i) { af[i] = *(const bf16x8*)(ap + (size_t)(16 * i) * lda + k); bf[i] = *(const bf16x8*)(bp + (size_t)(16 * i) * ldb + k); }
#pragma unroll
        for (int i = 0; i < 4; ++i)
#pragma unroll
            for (int j = 0; j < 4; ++j) acc[i][j] = __builtin_amdgcn_mfma_f32_16x16x32_bf16(bf[j], af[i], acc[i][j], 0, 0, 0);
    }
    __syncthreads();
    LAS float* part = (LAS float*)lds + wid * 4096;
#pragma unroll
    for (int i = 0; i < 4; ++i)
#pragma unroll
        for (int j = 0; j < 4; ++j) *(LAS f32x4*)(part + (16 * i + fr) * 64 + 16 * j + 4 * fq) = acc[i][j];
    __syncthreads();
    const int row = wid * 8 + (lane >> 3), c8 = (lane & 7) * 8;
    f32x4 s0 = {0.f, 0.f, 0.f, 0.f}, s1 = {0.f, 0.f, 0.f, 0.f};
#pragma unroll
    for (int w = 0; w < 8; ++w) { const LAS float* p = (const LAS float*)lds + w * 4096 + row * 64 + c8; s0 += *(const LAS f32x4*)p; s1 += *(const LAS f32x4*)(p + 4); }
    const int col = nb * 64 + c8; const size_t off = (size_t)(row0 + row) * D + col;
    if (colscale) { s0 = s0 * *(const f32x4*)(colscale + col); s1 = s1 * *(const f32x4*)(colscale + col + 4); }
    const f32x4 v0 = *(const f32x4*)(xin + off) + s0, v1 = *(const f32x4*)(xin + off + 4) + s1;
    *(f32x4*)(xout + off) = v0; *(f32x4*)(xout + off + 4) = v1;
    if (xb) { u32x4 w; w.x = cvt_pk_bf16(v0[0], v0[1]); w.y = cvt_pk_bf16(v0[2], v0[3]); w.z = cvt_pk_bf16(v1[0], v1[1]); w.w = cvt_pk_bf16(v1[2], v1[3]); *(u32x4*)(xb + off) = w; }
    float ss = ((v0[0] * v0[0] + v0[1] * v0[1]) + (v0[2] * v0[2] + v0[3] * v0[3])) + ((v1[0] * v1[0] + v1[1] * v1[1]) + (v1[2] * v1[2] + v1[3] * v1[3]));
    ss += __shfl_xor(ss, 1); ss += __shfl_xor(ss, 2); ss += __shfl_xor(ss, 4);
    if (rowp && (lane & 7) == 0) rowp[(size_t)(row0 + row) * 32 + nb] = ss;
    __syncthreads();
}

struct Args { const void* in[25]; float* out; unsigned char* ws; };
struct Frame {
    LAS unsigned char* lds; int tid, lane, wave, vcu, G;
};

__device__ __forceinline__ void tr_item(const float* W, int ldw, int k0, int nsrc0, int nvalid, const float* kscale, bf16_t* WT, int ldt, int ndst0, LAS float* scr, int lane) {
    const int r = lane >> 4, c4 = (lane & 15) * 4; const bool cv = nsrc0 + c4 < nvalid;
    f32x4 v[16];
#pragma unroll
    for (int i = 0; i < 16; ++i) v[i] = cv ? *(const f32x4*)(W + (size_t)(k0 + 4 * i + r) * ldw + nsrc0 + c4) : (f32x4){0.f, 0.f, 0.f, 0.f};
    if (kscale) {
#pragma unroll
        for (int i = 0; i < 16; ++i) v[i] = v[i] * kscale[k0 + 4 * i + r]; }
#pragma unroll
    for (int i = 0; i < 16; ++i) *(LAS f32x4*)(scr + (4 * i + r) * 64 + c4) = v[i];
    LDS_WAIT(); asm volatile("" ::: "memory");
    bf16_t* dst = WT + (size_t)(ndst0 + lane) * ldt + k0;
#pragma unroll
    for (int j = 0; j < 8; ++j) { const LAS float* p = scr + (8 * j) * 64 + lane;
        u32x4 o; o.x = cvt_pk_bf16(p[0], p[64]); o.y = cvt_pk_bf16(p[128], p[192]); o.z = cvt_pk_bf16(p[256], p[320]); o.w = cvt_pk_bf16(p[384], p[448]);
        *(u32x4*)(dst + 8 * j) = o; }
    LDS_WAIT(); asm volatile("" ::: "memory");
}

__device__ __forceinline__ void p0_prologue(const Args& a, const Frame& F) {
    unsigned char* ws = a.ws;
    LAS float* scr = (LAS float*)(F.lds + F.wave * 16384);
    const int gw = F.vcu * NWAVES + F.wave, NGW = F.G * NWAVES, lane = F.lane;
    const float* ln_mix = (const float*)a.in[8]; const float* ln_ffn = (const float*)a.in[9];
    constexpr int I_POOL = 8 * 8 * 8, I_WIN = 32 * 176, I_WOUT = 88 * 32, I_WKV = 32 * 48, I_WQG = 32 * 36, I_WO = 32 * 32, I_W1 = 32 * 2, I_W2 = 2 * 2;
    constexpr int NITEMS = I_POOL + 4 * I_WIN + 4 * I_WOUT + I_WKV + 2 * I_WQG + 2 * I_WO + 4 * I_W1 + 2 * I_W2;
    for (int it = gw; it < NITEMS; it += NGW) {
        int r = it;
        if (r < I_POOL) { const int mat = r >> 6, q = r & 63, kb = q >> 3, nb = q & 7;
            tr_item((const float*)a.in[10] + (size_t)mat * 512 * 512, 512, kb * 64, nb * 64, 512, nullptr, (bf16_t*)(ws + WS_WPOOL) + (size_t)mat * 512 * 512, 512, nb * 64, scr, lane); continue; } r -= I_POOL;
        if (r < 4 * I_WIN) { const int l = r / I_WIN, q = r % I_WIN, kb = q / 176, nb = q % 176; const int ns = nb * 64;
            const int f = ns < FF ? ns : ns - FF; const int nd = (f >> 7) * 256 + (ns < FF ? 0 : 128) + (f & 127);
            tr_item((const float*)a.in[21] + (size_t)l * D * FF2, FF2, kb * 64, ns, FF2, ln_ffn + l * D, (bf16_t*)(ws + WS_WIN) + (size_t)l * FF2 * D, D, nd, scr, lane); continue; } r -= 4 * I_WIN;
        if (r < 4 * I_WOUT) { const int l = r / I_WOUT, q = r % I_WOUT, kb = q >> 5, nb = q & 31;
            tr_item((const float*)a.in[24] + (size_t)l * FF * D, D, kb * 64, nb * 64, D, nullptr, (bf16_t*)(ws + WS_WOUT) + (size_t)l * D * FF, FF, nb * 64, scr, lane); continue; } r -= 4 * I_WOUT;
        if (r < I_WKV) { const int kb = r / 48, nb = r % 48;
            tr_item((const float*)a.in[13], KVW, kb * 64, nb * 64, KVW, (const float*)a.in[12], (bf16_t*)(ws + WS_WKVQG), D, nb * 64, scr, lane); continue; } r -= I_WKV;
        if (r < 2 * I_WQG) { const int j = r / I_WQG, q = r % I_WQG, kb = q / 36, nb = q % 36;
            bf16_t* dst = j == 0 ? (bf16_t*)(ws + WS_WKVQG) + (size_t)KVW * D : (bf16_t*)(ws + WS_WQG1);
            tr_item((const float*)a.in[18] + (size_t)j * D * QGW, QGW, kb * 64, nb * 64, QGW, ln_mix + (2 + j) * D, dst, D, nb * 64, scr, lane); continue; } r -= 2 * I_WQG;
        if (r < 2 * I_WO) { const int j = r / I_WO, q = r % I_WO, kb = q >> 5, nb = q & 31;
            tr_item((const float*)a.in[20] + (size_t)j * D * D, D, kb * 64, nb * 64, D, nullptr, (bf16_t*)(ws + WS_WO) + (size_t)j * D * D, D, nb * 64, scr, lane); continue; } r -= 2 * I_WO;
        if (r < 4 * I_W1) { const int vh = r / I_W1, q = r % I_W1, kb = q >> 1, nb = q & 1; const int v = vh >> 1, half = vh & 1;
            tr_item((const float*)a.in[15] + ((size_t)(v * 32 + half * 16) * 128) * 128, 128, kb * 64, nb * 64, 128, nullptr, (bf16_t*)(ws + WS_W1CAT) + (size_t)v * 256 * 2048, 2048, half * 128 + nb * 64, scr, lane); continue; } r -= 4 * I_W1;
        { const int v = r / I_W2, q = r % I_W2, kb = q >> 1, nb = q & 1;
            tr_item((const float*)a.in[17] + (size_t)v * 128 * 128, 128, kb * 64, nb * 64, 128, nullptr, (bf16_t*)(ws + WS_W2T) + (size_t)v * 128 * 128, 128, nb * 64, scr, lane); }
    }
    for (int it = gw; it < 256; it += NGW) { const int v = it >> 7, h = it & 127; const float* pos = (const float*)a.in[16] + (size_t)v * 4096; const float* w1 = (const float*)a.in[15] + (size_t)v * 4096 * 128 + h;
        float s = 0.f; for (int i = lane; i < 4096; i += 64) s += pos[i] * w1[(size_t)i * 128];
        s = wave_sum(s); if (lane == 0) ((float*)(ws + WS_CBIAS))[it] = s; }
    { float* X = (float*)(ws + WS_X); float* rowp = (float*)(ws + WS_ROWP);
      for (int m = gw; m < MR; m += NGW) { const float* src = m < MP ? (const float*)a.in[0] + (size_t)m * D : (const float*)a.in[1] + (size_t)(m - MP) * D;
          float s = 0.f;
#pragma unroll
          for (int j = 0; j < 8; ++j) { const f32x4 v = *((const f32x4*)src + lane + 64 * j); *((f32x4*)(X + (size_t)m * D) + lane + 64 * j) = v; s += (v[0] * v[0] + v[1] * v[1]) + (v[2] * v[2] + v[3] * v[3]); }
          s = wave_sum(s); if (lane < 32) rowp[(size_t)m * 32 + lane] = lane == 0 ? s : 0.f; } }
    { const float* cache = (const float*)a.in[2]; const int* pt = (const int*)a.in[4]; bf16_t* ACMP = (bf16_t*)(ws + WS_ACMP);
      for (int it = gw; it < NBS * 1024; it += NGW) { const int b = it >> 10, n = it & 1023; const int page = pt[b * 128 + (n >> 3)];
          const float* src = cache + ((size_t)page * 128 + (n & 7) * 16) * 1024;
#pragma unroll 8
          for (int s = 0; s < 16; ++s)
#pragma unroll
              for (int q = 0; q < 4; ++q) { const f32x4 v = __builtin_nontemporal_load((const f32x4*)(src + s * 1024 + q * 256) + lane); const int hq = q * 2 + (lane >> 5), vv = hq >> 2, g = hq & 3, d = (lane & 31) * 4;
                  u32x2 w; w.x = cvt_pk_bf16(v[0], v[1]); w.y = cvt_pk_bf16(v[2], v[3]);
                  *(u32x2*)(ACMP + ((size_t)CMP_ROW_S0 + (size_t)vv * 32768 + (size_t)(b * 4 + g) * 1024 + n) * 2048 + s * 128 + d) = w; } } }
    { const float* st = (const float*)a.in[5]; bf16_t* KW = (bf16_t*)(ws + WS_KWINS); bf16_t* VW = (bf16_t*)(ws + WS_VWINS); float* ow = a.out + O_WINS;
      for (int it = gw; it < NBS * 512; it += NGW) { const int b = it >> 9, i = it & 511; const float* src = st + (size_t)it * 1024;
#pragma unroll
          for (int q = 0; q < 4; ++q) { const f32x4 v = *((const f32x4*)(src + q * 256) + lane); const int hq = q * 2 + (lane >> 5), vv = hq >> 2, g = hq & 3, d = (lane & 31) * 4;
              u32x2 w; w.x = cvt_pk_bf16(v[0], v[1]); w.y = cvt_pk_bf16(v[2], v[3]);
              *(u32x2*)((vv ? VW : KW) + ((size_t)(b * 4 + g) * 576 + i) * 128 + d) = w;
              if (i >= 8) *((f32x4*)(ow + ((size_t)b * 512 + (i - 8)) * 1024 + q * 256) + lane) = v; } } }
    { const int gt = gw * 64 + lane, NGT = NGW * 64; const u32x4 z = {0u, 0u, 0u, 0u};
      for (int i = gt; i < (int)(MiB / 16); i += NGT) { *((u32x4*)(ws + WS_KCP) + i) = z; *((u32x4*)(ws + WS_KSELNS) + i) = z; }
      for (int i = gt; i < 32 * 16; i += NGT) { const int bg = i >> 4, c = i & 15; *((u32x4*)(ws + WS_KCS + ((size_t)bg * 1024 + 1023) * 256) + c) = z; *((u32x4*)(ws + WS_VCS + ((size_t)bg * 1024 + 1023) * 256) + c) = z; }
      for (int i = gt; i < 32 * 56 * 16; i += NGT) { const int bg = i / (56 * 16), r = i % (56 * 16); *((u32x4*)(ws + WS_KWINS + ((size_t)bg * 576 + 520) * 256) + r) = z; *((u32x4*)(ws + WS_VWINS + ((size_t)bg * 576 + 520) * 256) + r) = z; } }
}

__device__ __forceinline__ void pool_pass(const Args& a, const Frame& F, int l) {
    unsigned char* ws = a.ws; const float* X = (const float*)(ws + WS_X); const float* rowp = (const float*)(ws + WS_ROWP + (size_t)(2 * l) * ROWP_STRIDE);
    const float* gain = (const float*)a.in[8] + l * D; bf16_t* PO = (bf16_t*)(ws + WS_POOLED);
    LAS float* ctx = (LAS float*)F.lds; LAS float* rs = (LAS float*)(F.lds + 47 * 512 * 4);
    const int tid = F.tid;
    constexpr int NUP = (MP / 32) * 4, NU = NUP + NBS * 4;
    for (int u = F.vcu; u < NU; u += F.G) {
        __syncthreads();
        if (u < NUP) {
            const int g = u & 3, rt = u >> 2, b = rt >> 7, t0 = (rt & 127) * 32, w = 2 << g;
            if (tid < 47) { const int t = t0 - 15 + tid; rs[tid] = t >= 0 ? row_rstd(rowp, b * SEQ + t) : 0.f; }
            __syncthreads();
            { const int c4 = tid & 127; const f32x4 gv = *((const f32x4*)(gain + g * 512) + c4);
              for (int r = tid >> 7; r < 47; r += 4) { const int t = t0 - 15 + r; f32x4 v = {0.f, 0.f, 0.f, 0.f};
                  if (t >= 0) { v = *((const f32x4*)(X + (size_t)(b * SEQ + t) * D + g * 512) + c4); v = v * rs[r] * gv; }
                  *((LAS f32x4*)(ctx + r * 512) + c4) = v; } }
            __syncthreads();
            { const int cp = tid & 255, half = tid >> 8, r0 = 15 + half * 16; float s0 = 0.f, s1 = 0.f;
              for (int i = 1; i < w; ++i) { const f32x2 v = *(const LAS f32x2*)(ctx + (r0 - i) * 512 + 2 * cp); s0 += v[0]; s1 += v[1]; }
              for (int i = 0; i < 16; ++i) { const int r = r0 + i, t = t0 + half * 16 + i; const f32x2 h = *(const LAS f32x2*)(ctx + r * 512 + 2 * cp); s0 += h[0]; s1 += h[1];
                  const float inv = 1.0f / (float)(t + 1 < w ? t + 1 : w);
                  *(unsigned*)(PO + (size_t)(b * SEQ + t) * D + g * 512 + 2 * cp) = cvt_pk_bf16(s0 * inv - h[0], s1 * inv - h[1]);
                  const f32x2 o = *(const LAS f32x2*)(ctx + (r - w + 1) * 512 + 2 * cp); s0 -= o[0]; s1 -= o[1]; } }
            if (t0 == SEQ - 32) { float* op = a.out + O_POOLP + ((size_t)(l * NBP + b) * 15) * D + g * 512;
                for (int i = tid; i < 15 * 512; i += NTHR) { const int r = i >> 9, c = i & 511; op[(size_t)r * D + c] = ctx[(32 + r) * 512 + c]; } }
        } else {
            const int us = u - NUP, g = us & 3, b = us >> 2, w = 2 << g; const float* sp = (const float*)a.in[6] + ((size_t)(l * NBS + b) * 15) * D + g * 512;
            if (tid < 8) rs[tid] = row_rstd(rowp, MP + b * 8 + tid);
            __syncthreads();
            for (int i = tid; i < 23 * 512; i += NTHR) { const int r = i >> 9, c = i & 511;
                ctx[i] = r < 15 ? sp[(size_t)r * D + c] : X[(size_t)(MP + b * 8 + r - 15) * D + g * 512 + c] * rs[r - 15] * gain[g * 512 + c]; }
            __syncthreads();
            { const int c = tid; const float inv = 1.0f / (float)w;
              for (int t = 0; t < 8; ++t) { float s = 0.f; for (int i = 0; i < w; ++i) s += ctx[(15 + t - i) * 512 + c];
                  PO[(size_t)(MP + b * 8 + t) * D + g * 512 + c] = (bf16_t)(cvt_pk_bf16(s * inv - ctx[(15 + t) * 512 + c], 0.f) & 0xffffu); } }
            { float* op = a.out + O_POOLS + ((size_t)(l * NBS + b) * 15) * D + g * 512;
              for (int i = tid; i < 15 * 512; i += NTHR) { const int r = i >> 9, c = i & 511; op[(size_t)r * D + c] = ctx[(8 + r) * 512 + c]; } }
        }
    }
    __syncthreads();
}

__device__ __forceinline__ void convgate_pass(const Args& a, const Frame& F, int l) {
    unsigned char* ws = a.ws; const bf16_t* HH = (const bf16_t*)(ws + WS_HH); bf16_t* ACT = (bf16_t*)(ws + WS_ACT);
    const float* cw = (const float*)a.in[22] + (size_t)l * 3 * FF2; const float* cb = (const float*)a.in[23] + (size_t)l * FF2; const float* sc = (const float*)a.in[7] + (size_t)l * NBS * 2 * FF2;
    const int gw = F.vcu * NWAVES + F.wave, NGW = F.G * NWAVES, lane = F.lane;
    constexpr int NCH_P = MP / 16, NIT = (NCH_P + NBS) * 11;
    for (int it = gw; it < NIT; it += NGW) {
        const int fg = it % 11, ch = it / 11; const int f0 = fg * 512 + lane * 8, pn = f0 >> 7, j0 = f0 & 127;
        const bool samp = ch >= NCH_P; const int bs = ch - NCH_P; const int m0 = samp ? MP + bs * 8 : ch * 16, nrow = samp ? 8 : 16; const bool seq_start = samp || ((ch & 255) == 0);
        float wg[3][8], wv[3][8], bg[8], bv[8];
#pragma unroll
        for (int k = 0; k < 3; ++k) { const f32x4 a0 = *(const f32x4*)(cw + k * FF2 + f0), a1 = *(const f32x4*)(cw + k * FF2 + f0 + 4), c0 = *(const f32x4*)(cw + k * FF2 + FF + f0), c1 = *(const f32x4*)(cw + k * FF2 + FF + f0 + 4);
#pragma unroll
            for (int i = 0; i < 4; ++i) { wg[k][i] = a0[i]; wg[k][4 + i] = a1[i]; wv[k][i] = c0[i]; wv[k][4 + i] = c1[i]; } }
        { const f32x4 a0 = *(const f32x4*)(cb + f0), a1 = *(const f32x4*)(cb + f0 + 4), c0 = *(const f32x4*)(cb + FF + f0), c1 = *(const f32x4*)(cb + FF + f0 + 4);
#pragma unroll
          for (int i = 0; i < 4; ++i) { bg[i] = a0[i]; bg[4 + i] = a1[i]; bv[i] = c0[i]; bv[4 + i] = c1[i]; } }
        float g2[8], g1[8], v2[8], v1[8];
        const size_t colg = (size_t)pn * 256 + j0;
        if (seq_start) {
            if (samp) { const float* p0 = sc + ((size_t)bs * 2 + 0) * FF2, *p1 = sc + ((size_t)bs * 2 + 1) * FF2;
#pragma unroll
                for (int i = 0; i < 8; ++i) { g2[i] = p0[f0 + i]; v2[i] = p0[FF + f0 + i]; g1[i] = p1[f0 + i]; v1[i] = p1[FF + f0 + i]; } }
            else {
#pragma unroll
                for (int i = 0; i < 8; ++i) { g2[i] = 0.f; g1[i] = 0.f; v2[i] = 0.f; v1[i] = 0.f; } }
        } else {
            const bf16x8 a2 = *(const bf16x8*)(HH + (size_t)(m0 - 2) * FF2 + colg), a1 = *(const bf16x8*)(HH + (size_t)(m0 - 1) * FF2 + colg);
            const bf16x8 c2 = *(const bf16x8*)(HH + (size_t)(m0 - 2) * FF2 + colg + 128), c1 = *(const bf16x8*)(HH + (size_t)(m0 - 1) * FF2 + colg + 128);
#pragma unroll
            for (int i = 0; i < 8; ++i) { g2[i] = bf2f((bf16_t)a2[i]); g1[i] = bf2f((bf16_t)a1[i]); v2[i] = bf2f((bf16_t)c2[i]); v1[i] = bf2f((bf16_t)c1[i]); }
        }
        for (int r = 0; r < nrow; ++r) {
            const bf16x8 ag = *(const bf16x8*)(HH + (size_t)(m0 + r) * FF2 + colg), av = *(const bf16x8*)(HH + (size_t)(m0 + r) * FF2 + colg + 128);
            float o[8];
#pragma unroll
            for (int i = 0; i < 8; ++i) { const float hg = bf2f((bf16_t)ag[i]), hv = bf2f((bf16_t)av[i]);
                const float cg = bg[i] + wg[0][i] * g2[i] + wg[1][i] * g1[i] + wg[2][i] * hg, cv = bv[i] + wv[0][i] * v2[i] + wv[1][i] * v1[i] + wv[2][i] * hv;
                o[i] = cg / (1.0f + __expf(-cg)) * cv; g2[i] = g1[i]; g1[i] = hg; v2[i] = v1[i]; v1[i] = hv; }
            u32x4 w; w.x = cvt_pk_bf16(o[0], o[1]); w.y = cvt_pk_bf16(o[2], o[3]); w.z = cvt_pk_bf16(o[4], o[5]); w.w = cvt_pk_bf16(o[6], o[7]);
            *(u32x4*)(ACT + (size_t)(m0 + r) * FF + f0) = w;
        }
    }
}

__device__ __forceinline__ void kvpost_pass(const Args& a, const Frame& F) {
    unsigned char* ws = a.ws; const float* KV = (const float*)(ws + WS_KV); const float* knorm = (const float*)a.in[14];
    const int gw = F.vcu * NWAVES + F.wave, NGW = F.G * NWAVES, lane = F.lane;
    bf16_t* ACMP = (bf16_t*)(ws + WS_ACMP);
    for (int m = gw; m < MR; m += NGW) {
        const bool samp = m >= MP; const int b = samp ? (m - MP) >> 3 : m >> 12, t = samp ? (m - MP) & 7 : m & (SEQ - 1);
#pragma unroll 2
        for (int e = 0; e < 24; ++e) {
            const int br = e >> 3, v = (e >> 2) & 1, g = e & 3, bg = b * 4 + g;
            f32x2 raw = *(const f32x2*)(KV + (size_t)m * KVW + e * 128 + 2 * lane);
            if (br > 0 && v == 0) { const float ss = wave_sum(raw[0] * raw[0] + raw[1] * raw[1]); const float rstd = 1.0f / sqrtf(ss * (1.0f / 128.0f) + EPS);
                const f32x2 kn = *(const f32x2*)(knorm + br * 128 + 2 * lane); raw = raw * rstd * kn; }
            const unsigned pk = cvt_pk_bf16(raw[0], raw[1]); const size_t oe = (size_t)(v * 4 + g) * 128 + 2 * lane;
            if (br == 0) {
                if (!samp) { *(f32x2*)(a.out + O_CMPP + (size_t)m * 1024 + oe) = raw;
                    *(unsigned*)(ACMP + ((size_t)v * 2048 + (size_t)bg * 256 + (t >> 4)) * 2048 + (t & 15) * 128 + 2 * lane) = pk; }
                else *(f32x2*)(a.out + O_CMPS + (size_t)(m - MP) * 1024 + oe) = raw;
            } else if (br == 1) {
                if (!samp) { *(f32x2*)(a.out + O_SELP + (size_t)m * 1024 + oe) = raw;
                    *(unsigned*)((bf16_t*)(ws + (v ? WS_VSEL : WS_KSEL)) + ((size_t)bg * SEQ + t) * 128 + 2 * lane) = pk; }
                else { *(f32x2*)(a.out + O_SELS + (size_t)(m - MP) * 1024 + oe) = raw;
                    *(unsigned*)((bf16_t*)(ws + (v ? WS_VSELNS : WS_KSELNS)) + ((size_t)bg * 64 + t) * 128 + 2 * lane) = pk; }
            } else {
                if (!samp) { *(unsigned*)((bf16_t*)(ws + (v ? WS_VWIN : WS_KWIN)) + ((size_t)bg * SEQ + t) * 128 + 2 * lane) = pk;
                    if (t >= SEQ - 512) *(f32x2*)(a.out + O_WINP + ((size_t)b * 512 + (t - (SEQ - 512))) * 1024 + oe) = raw; }
                else { *(unsigned*)((bf16_t*)(ws + (v ? WS_VWINS : WS_KWINS)) + ((size_t)bg * 576 + 512 + t) * 128 + 2 * lane) = pk;
                    *(f32x2*)(a.out + O_WINS + ((size_t)b * 512 + 504 + t) * 1024 + oe) = raw; }
            }
        }
    }
}

__device__ __forceinline__ int crow(int r, int hi) { return (r & 3) + 8 * (r >> 2) + 4 * hi; }
__device__ __forceinline__ float gelu_tanh(float x) { const float u = 0.7978845608028654f * (x + 0.044715f * x * x * x); const float e = __expf(2.0f * u); const float th = 1.0f - 2.0f / (1.0f + e); return 0.5f * x * (1.0f + th); }
__device__ __forceinline__ void cmppost_pass(const Args& a, const Frame& F) {
    unsigned char* ws = a.ws; const float* P = (const float*)(ws + WS_PCMP); const bf16_t* W2T = (const bf16_t*)(ws + WS_W2T); const float* bias = (const float*)(ws + WS_CBIAS);
    const float* kn0 = (const float*)a.in[14];
    const int gw = F.vcu * NWAVES + F.wave, NGW = F.G * NWAVES, lane = F.lane, r32 = lane & 31, hi = lane >> 5;
    constexpr int NIT_P = 2 * 4 * 2 * 8, NIT = NIT_P + 8 * 4 * 2 * 32;
    for (int it = gw; it < NIT; it += NGW) {
        int sgb, g, v, ch, NC, pitch; size_t prow0; bf16_t* dst;
        if (it < NIT_P) { ch = it & 7; v = (it >> 3) & 1; g = (it >> 4) & 3; sgb = it >> 6; NC = NCP; pitch = 256; prow0 = (size_t)v * 2048 + (size_t)(sgb * 4 + g) * 256;
            dst = (bf16_t*)(ws + (v ? WS_VCP : WS_KCP)) + (size_t)(sgb * 4 + g) * 256 * 128; }
        else { const int q = it - NIT_P; ch = q & 31; v = (q >> 5) & 1; g = (q >> 6) & 3; sgb = q >> 8; NC = NCS; pitch = 1024; prow0 = (size_t)CMP_ROW_S0 + (size_t)v * 32768 + (size_t)(sgb * 4 + g) * 1024;
            dst = (bf16_t*)(ws + (v ? WS_VCS : WS_KCS)) + (size_t)(sgb * 4 + g) * 1024 * 128; }
        const int i = ch * 32 + r32; const bool iv = i < NC;
        bf16x8 af[8];
#pragma unroll
        for (int ks = 0; ks < 8; ++ks) { const int h0 = ks * 16 + hi * 8; float hv[8];
            if (iv) { const f32x4 p0 = *(const f32x4*)(P + (prow0 + i) * 256 + h0), p1 = *(const f32x4*)(P + (prow0 + i) * 256 + h0 + 4);
                const f32x4 q0 = *(const f32x4*)(P + (prow0 + i + 1) * 256 + 128 + h0), q1 = *(const f32x4*)(P + (prow0 + i + 1) * 256 + 128 + h0 + 4);
                const f32x4 b0 = *(const f32x4*)(bias + v * 128 + h0), b1 = *(const f32x4*)(bias + v * 128 + h0 + 4);
#pragma unroll
                for (int e = 0; e < 4; ++e) { hv[e] = gelu_tanh(p0[e] + q0[e] + b0[e]); hv[4 + e] = gelu_tanh(p1[e] + q1[e] + b1[e]); } }
            else {
#pragma unroll
                for (int e = 0; e < 8; ++e) hv[e] = 0.f; }
            u32x4 w; w.x = cvt_pk_bf16(hv[0], hv[1]); w.y = cvt_pk_bf16(hv[2], hv[3]); w.z = cvt_pk_bf16(hv[4], hv[5]); w.w = cvt_pk_bf16(hv[6], hv[7]); af[ks] = __builtin_bit_cast(bf16x8, w); }
        f32x16 o[4];
#pragma unroll
        for (int d0 = 0; d0 < 4; ++d0) { o[d0] = (f32x16){};
#pragma unroll
            for (int ks = 0; ks < 8; ++ks) { const bf16x8 bfr = *(const bf16x8*)(W2T + (size_t)v * 128 * 128 + (size_t)(32 * d0 + r32) * 128 + ks * 16 + hi * 8);
                o[d0] = __builtin_amdgcn_mfma_f32_32x32x16_bf16(af[ks], bfr, o[d0], 0, 0, 0); } }
#pragma unroll
        for (int r = 0; r < 16; ++r) {
            float sc = 1.0f;
            if (v == 0) { float ss = o[0][r] * o[0][r] + o[1][r] * o[1][r] + o[2][r] * o[2][r] + o[3][r] * o[3][r];
                ss += __shfl_xor(ss, 1); ss += __shfl_xor(ss, 2); ss += __shfl_xor(ss, 4); ss += __shfl_xor(ss, 8); ss += __shfl_xor(ss, 16);
                sc = 1.0f / sqrtf(ss * (1.0f / 128.0f) + EPS); }
            const int ir = ch * 32 + crow(r, hi);
            if (ir < NC) {
#pragma unroll
                for (int d0 = 0; d0 < 4; ++d0) { const int d = 32 * d0 + r32; const float val = v == 0 ? o[d0][r] * sc * kn0[d] : o[d0][r];
                    dst[(size_t)ir * 128 + d] = (bf16_t)(cvt_pk_bf16(val, 0.f) & 0xffffu); } }
        }
    }
}

namespace nsa {
#define KSWZ(row, colB) ((row) * 256 + ((colB) ^ (((row) & 7) << 4)))
constexpr float LOG2E = 1.4426950408889634f;
constexpr int L_K = 0, L_V = 16384, L_PQ = 32768, L_SELM = 98304, L_WUN = L_SELM + 64 * 5 * 8, L_WSF = L_WUN + 8 * 5 * 8, L_END = L_WSF + 8 * 64 * 4;
static_assert(L_END <= RING_BYTES, "attention LDS");
__device__ __forceinline__ int v_st(int k, int c) { const int kk = (k & ~0xC) | ((k & 4) << 1) | ((k & 8) >> 1); return ((kk >> 3) * 4 + (c >> 5)) * 512 + ((kk & 7) * 32 + (c & 31)) * 2; }
__device__ __forceinline__ int v_rd_base(int lane) { return ((lane & 3) << 3) | (((lane >> 2) & 3) << 6) | (((lane >> 4) & 1) << 5) | (((lane >> 5) & 1) << 8); }
constexpr int v_rd_off(int d0, int ks, int half) { return d0 * 512 + ks * 4096 + half * 2048; }
template <int OFF> __device__ __forceinline__ s16x4 tr_read(int vb) { s16x4 r; asm volatile("ds_read_b64_tr_b16 %0, %1 offset:%2" : "=&v"(r) : "v"(vb), "i"(OFF) : "memory"); return r; }
template <int D0> __device__ __forceinline__ void pv_one(f32x16& od, int vb, bf16x8 pa0, bf16x8 pa1, bf16x8 pa2, bf16x8 pa3) {
    const s16x4 l0 = tr_read<v_rd_off(D0, 0, 0)>(vb), h0 = tr_read<v_rd_off(D0, 0, 1)>(vb), l1 = tr_read<v_rd_off(D0, 1, 0)>(vb), h1 = tr_read<v_rd_off(D0, 1, 1)>(vb);
    const s16x4 l2 = tr_read<v_rd_off(D0, 2, 0)>(vb), h2 = tr_read<v_rd_off(D0, 2, 1)>(vb), l3 = tr_read<v_rd_off(D0, 3, 0)>(vb), h3 = tr_read<v_rd_off(D0, 3, 1)>(vb);
    asm volatile("s_waitcnt lgkmcnt(0)" ::: "memory"); SBAR();
#define PK(L, H) (bf16x8){L[0], L[1], L[2], L[3], H[0], H[1], H[2], H[3]}
    od = __builtin_amdgcn_mfma_f32_32x32x16_bf16(pa0, PK(l0, h0), od, 0, 0, 0);
    od = __builtin_amdgcn_mfma_f32_32x32x16_bf16(pa1, PK(l1, h1), od, 0, 0, 0);
    od = __builtin_amdgcn_mfma_f32_32x32x16_bf16(pa2, PK(l2, h2), od, 0, 0, 0);
    od = __builtin_amdgcn_mfma_f32_32x32x16_bf16(pa3, PK(l3, h3), od, 0, 0, 0);
#undef PK
}
__device__ __forceinline__ void pv_d0(f32x16* o, int vb, bf16x8 pa0, bf16x8 pa1, bf16x8 pa2, bf16x8 pa3) {
    pv_one<0>(o[0], vb, pa0, pa1, pa2, pa3); pv_one<1>(o[1], vb, pa0, pa1, pa2, pa3); pv_one<2>(o[2], vb, pa0, pa1, pa2, pa3); pv_one<3>(o[3], vb, pa0, pa1, pa2, pa3);
}
__device__ __forceinline__ void qkt(f32x16& p0, f32x16& p1, const LAS unsigned char* Ks, const bf16x8* qr, int r32, int hi) {
    p0 = (f32x16){}; p1 = (f32x16){};
#pragma unroll
    for (int d0 = 0; d0 < 8; ++d0) { const int cb = (d0 * 16 + hi * 8) * 2;
        const bf16x8 b0 = *(const LAS bf16x8*)(Ks + KSWZ(r32, cb)); const bf16x8 b1 = *(const LAS bf16x8*)(Ks + KSWZ(32 + r32, cb));
        p0 = __builtin_amdgcn_mfma_f32_32x32x16_bf16(b0, qr[d0], p0, 0, 0, 0);
        p1 = __builtin_amdgcn_mfma_f32_32x32x16_bf16(b1, qr[d0], p1, 0, 0, 0); }
}
__device__ __forceinline__ void p_to_frags(const f32x16& p0, const f32x16& p1, bf16x8& pa0, bf16x8& pa1, bf16x8& pa2, bf16x8& pa3) {
#define PK4(P, BASE, OUT) do { unsigned a0 = cvt_pk_bf16(P[BASE + 0], P[BASE + 1]), a1 = cvt_pk_bf16(P[BASE + 2], P[BASE + 3]);   \
    unsigned b0 = cvt_pk_bf16(P[BASE + 4], P[BASE + 5]), b1 = cvt_pk_bf16(P[BASE + 6], P[BASE + 7]);                              \
    auto r0 = __builtin_amdgcn_permlane32_swap(a0, b0, false, false); auto r1 = __builtin_amdgcn_permlane32_swap(a1, b1, false, false); \
    u32x4 w = {r0[0], r1[0], r0[1], r1[1]}; OUT = __builtin_bit_cast(bf16x8, w); } while (0)
    PK4(p0, 0, pa0); PK4(p0, 8, pa1); PK4(p1, 0, pa2); PK4(p1, 8, pa3);
#undef PK4
}
__device__ __forceinline__ float half_swap_max(float v) { auto rr = __builtin_amdgcn_permlane32_swap(__float_as_uint(v), __float_as_uint(v), false, false); return fmaxf(__uint_as_float(rr[0]), __uint_as_float(rr[1])); }
__device__ __forceinline__ float half_swap_sum(float v) { auto rr = __builtin_amdgcn_permlane32_swap(__float_as_uint(v), __float_as_uint(v), false, false); return __uint_as_float(rr[0]) + __uint_as_float(rr[1]); }

__device__ __forceinline__ void stage_bf16(LAS unsigned char* lds, const bf16_t* kp, const bf16_t* vp, bool with_v, int tid_in) {
    int tid = tid_in; asm volatile("" : "+v"(tid));
    const int sr = tid >> 4, sc = (tid & 15) * 8; const unsigned o0 = (unsigned)(sr * 128 + sc) * 2u, o1 = o0 + 32u * 128u * 2u;
    const bf16x8 k0 = *(const bf16x8*)((const char*)kp + o0), k1 = *(const bf16x8*)((const char*)kp + o1);
    bf16x8 v0, v1;
    if (with_v) { v0 = *(const bf16x8*)((const char*)vp + o0); v1 = *(const bf16x8*)((const char*)vp + o1); }
    *(LAS bf16x8*)(lds + L_K + KSWZ(sr, sc * 2)) = k0; *(LAS bf16x8*)(lds + L_K + KSWZ(32 + sr, sc * 2)) = k1;
    if (with_v) { *(LAS bf16x8*)(lds + L_V + v_st(sr, sc)) = v0; *(LAS bf16x8*)(lds + L_V + v_st(32 + sr, sc)) = v1; }
}
__device__ __forceinline__ bf16x8 cvt8(const float* p) { const f32x4 a = *(const f32x4*)p, b = *(const f32x4*)(p + 4);
    u32x4 w; w.x = cvt_pk_bf16(a[0], a[1]); w.y = cvt_pk_bf16(a[2], a[3]); w.z = cvt_pk_bf16(b[0], b[1]); w.w = cvt_pk_bf16(b[2], b[3]); return __builtin_bit_cast(bf16x8, w); }
__device__ __forceinline__ void stage_f32(LAS unsigned char* lds, const float* kp, int tid_in) {
    int tid = tid_in; asm volatile("" : "+v"(tid));
    const int sr = tid >> 4, sc = (tid & 15) * 8; const unsigned o0 = (unsigned)(sr * 1024 + sc), o1 = o0 + 32u * 1024u;
    { const bf16x8 k0 = cvt8(kp + o0), k1 = cvt8(kp + o1);
      *(LAS bf16x8*)(lds + L_K + KSWZ(sr, sc * 2)) = k0; *(LAS bf16x8*)(lds + L_K + KSWZ(32 + sr, sc * 2)) = k1; }
    { const bf16x8 v0 = cvt8(kp + o0 + 512), v1 = cvt8(kp + o1 + 512);
      *(LAS bf16x8*)(lds + L_V + v_st(sr, sc)) = v0; *(LAS bf16x8*)(lds + L_V + v_st(32 + sr, sc)) = v1; }
}

__device__ __forceinline__ void mask_tile(f32x16& p0, f32x16& p1, int tpos, int pos0, int pstride, int dmax, bool rowok, float slope2, int hi) {
    const float NEG = -INFINITY;
#pragma unroll
    for (int r = 0; r < 16; ++r) { const int kk = (r & 3) + 8 * (r >> 2) + 4 * hi;
        const int d0 = tpos - (pos0 + pstride * kk), d1 = d0 - 32 * pstride;
        p0[r] = (rowok && d0 >= 0 && d0 < dmax) ? p0[r] - slope2 * (float)d0 : NEG;
        p1[r] = (rowok && d1 >= 0 && d1 < dmax) ? p1[r] - slope2 * (float)d1 : NEG; }
}
__device__ __forceinline__ void softmax_pv(f32x16& p0, f32x16& p1, float& m_reg, float& l_reg, f32x16* o, int vb, LAS float* wsf, int r32, int hi) {
    float pmax = p0[0];
#pragma unroll
    for (int r = 1; r < 16; ++r) pmax = fmaxf(pmax, p0[r]);
#pragma unroll
    for (int r = 0; r < 16; ++r) pmax = fmaxf(pmax, p1[r]);
    pmax = half_swap_max(pmax);
    const float mn = fmaxf(m_reg, pmax); const float alpha = __builtin_amdgcn_exp2f(m_reg - mn); m_reg = mn;
    float ps = 0.f;
#pragma unroll
    for (int r = 0; r < 16; ++r) { p0[r] = __builtin_amdgcn_exp2f(p0[r] - mn); p1[r] = __builtin_amdgcn_exp2f(p1[r] - mn); ps += p0[r] + p1[r]; }
    ps = half_swap_sum(ps);
    l_reg = l_reg * alpha + ps;
    if (__any(alpha < 1.f)) { if (hi == 0) wsf[r32] = alpha; LDS_WAIT();
#pragma unroll
        for (int r = 0; r < 16; ++r) { const float al = wsf[crow(r, hi)];
#pragma unroll
            for (int d = 0; d < 4; ++d) o[d][r] *= al; }
        LDS_WAIT(); }
    bf16x8 pa0, pa1, pa2, pa3; p_to_frags(p0, p1, pa0, pa1, pa2, pa3);
    pv_d0(o, vb, pa0, pa1, pa2, pa3);
}
template <int MODE>
__device__ __forceinline__ void flush_branch(const f32x16* o, float f, float* OF, bf16_t* OB, int mbase, int g, int nq, int wid, LAS float* wsf, int r32, int hi) {
    LDS_WAIT(); if (hi == 0) wsf[r32] = f; LDS_WAIT();
#pragma unroll
    for (int r = 0; r < 16; ++r) { const int rr = crow(r, hi), hr = rr >> 3, qrow = wid * 8 + (rr & 7); const float fr = wsf[rr];
        if (qrow < nq) { const size_t base = (size_t)(mbase + qrow) * D + (g * 4 + hr) * 128 + r32;
#pragma unroll
            for (int d0 = 0; d0 < 4; ++d0) { float v = fr * o[d0][r];
                if (MODE > 0) v += __hip_atomic_load(OF + base + 32 * d0, __ATOMIC_RELAXED, __HIP_MEMORY_SCOPE_AGENT);
                if (MODE < 2) OF[base + 32 * d0] = v; else OB[base + 32 * d0] = (bf16_t)(cvt_pk_bf16(v, 0.f) & 0xffffu); } } }
    LDS_WAIT();
}

__device__ __forceinline__ void attn_unit(const Args& a, const Frame& F, int lj, bool samp, int b, int g, int qt) {
    unsigned char* ws = a.ws; LAS unsigned char* lds = F.lds;
    const int tid = F.tid, wid = F.wave, lane = F.lane, r32 = lane & 31, hi = lane >> 5;
    const int head = r32 >> 3, qi = r32 & 7, qq = wid * 8 + qi, nq = samp ? 8 : 64, bg = b * 4 + g;
    const bool rowok = qq < nq; const bool wactive = samp ? (wid == 0) : true;
    const int t0 = samp ? PAST : qt * 64, tpos = t0 + qq;
    const int mbase = samp ? MP + b * 8 : b * SEQ + qt * 64;
    const int mrow = mbase + (rowok ? qq : 0);
    const int hg = g * 4 + head;
    const float slope2 = exp2f(-0.5f * (float)(hg + 1)) * LOG2E;
    LAS float* wsf = (LAS float*)(lds + L_WSF) + wid * 64;
    LAS float* Pq = (LAS float*)(lds + L_PQ); const int pq_pitch = samp ? 1024 : 256;
    LAS u64* selm = (LAS u64*)(lds + L_SELM); LAS u64* wun = (LAS u64*)(lds + L_WUN);
    const int vb = (int)(uintptr_t)(lds + L_V) + v_rd_base(lane);
    const float* QG = (const float*)(ws + WS_QG);
    bf16x8 qr[8];
    { const float* qp = QG + (size_t)mrow * QGP + hg * 128 + hi * 8; const float* qn = (const float*)a.in[19] + lj * 128 + hi * 8;
      f32x4 qa[8][2]; float ss = 0.f;
#pragma unroll
      for (int d0 = 0; d0 < 8; ++d0) { qa[d0][0] = *(const f32x4*)(qp + d0 * 16); qa[d0][1] = *(const f32x4*)(qp + d0 * 16 + 4);
#pragma unroll
          for (int e = 0; e < 4; ++e) ss += qa[d0][0][e] * qa[d0][0][e] + qa[d0][1][e] * qa[d0][1][e]; }
      ss = half_swap_sum(ss);
      const float sc = (1.0f / sqrtf(ss * (1.0f / 128.0f) + EPS)) * 0.08838834764831845f * LOG2E;
#pragma unroll
      for (int d0 = 0; d0 < 8; ++d0) { const f32x4 n0 = *(const f32x4*)(qn + d0 * 16), n1 = *(const f32x4*)(qn + d0 * 16 + 4); const f32x4 x0 = qa[d0][0] * n0 * sc, x1 = qa[d0][1] * n1 * sc;
          u32x4 w; w.x = cvt_pk_bf16(x0[0], x0[1]); w.y = cvt_pk_bf16(x0[2], x0[3]); w.z = cvt_pk_bf16(x1[0], x1[1]); w.w = cvt_pk_bf16(x1[2], x1[3]); qr[d0] = __builtin_bit_cast(bf16x8, w); } }
    float gate[3];
#pragma unroll
    for (int br = 0; br < 3; ++br) { const float x = QG[(size_t)mrow * QGP + 2048 + hg * 3 + br]; gate[br] = 1.0f / (1.0f + __expf(-x)); }

    f32x16 o[4]; float* OF = (float*)(ws + WS_OF32); bf16_t* OBp = (bf16_t*)(ws + WS_OB);
    const int ncv = samp ? NCS : (4 * qt + 3 < NCP ? 4 * qt + 3 : NCP); const int ntc = (ncv + 63) >> 6;
    const bf16_t* KC = (const bf16_t*)(ws + (samp ? WS_KCS : WS_KCP)) + (size_t)bg * (samp ? 1024 : 256) * 128;
    const bf16_t* VC = (const bf16_t*)(ws + (samp ? WS_VCS : WS_VCP)) + (size_t)bg * (samp ? 1024 : 256) * 128;
    float m_c = -1e30f, l_c = 0.f;
    for (int tl = 0; tl < ntc; ++tl) {
        __syncthreads();
        stage_bf16(lds, KC + (size_t)tl * 64 * 128, nullptr, false, tid);
        __syncthreads();
        if (wactive) { f32x16 p0, p1; qkt(p0, p1, lds + L_K, qr, r32, hi);
            mask_tile(p0, p1, tpos, 16 * 64 * tl + 31, 16, 1 << 30, rowok, slope2, hi);
            float pmax = p0[0];
#pragma unroll
            for (int r = 1; r < 16; ++r) pmax = fmaxf(pmax, p0[r]);
#pragma unroll
            for (int r = 0; r < 16; ++r) pmax = fmaxf(pmax, p1[r]);
            pmax = half_swap_max(pmax);
            const float mn = fmaxf(m_c, pmax); float ps = 0.f;
#pragma unroll
            for (int r = 0; r < 16; ++r) ps += __builtin_amdgcn_exp2f(p0[r] - mn) + __builtin_amdgcn_exp2f(p1[r] - mn);
            ps = half_swap_sum(ps);
            l_c = l_c * __builtin_amdgcn_exp2f(m_c - mn) + ps; m_c = mn; }
    }
#pragma unroll
    for (int d = 0; d < 4; ++d) o[d] = (f32x16){};
    const float inv_c = l_c > 0.f ? 1.0f / l_c : 0.f;
    for (int tl = 0; tl < ntc; ++tl) {
        __syncthreads();
        stage_bf16(lds, KC + (size_t)tl * 64 * 128, VC + (size_t)tl * 64 * 128, true, tid);
        __syncthreads();
        if (wactive) { f32x16 p0, p1; qkt(p0, p1, lds + L_K, qr, r32, hi);
            mask_tile(p0, p1, tpos, 16 * 64 * tl + 31, 16, 1 << 30, rowok, slope2, hi);
#pragma unroll
            for (int r = 0; r < 16; ++r) { p0[r] = __builtin_amdgcn_exp2f(p0[r] - m_c) * inv_c; p1[r] = __builtin_amdgcn_exp2f(p1[r] - m_c) * inv_c; }
#pragma unroll
            for (int r = 0; r < 16; ++r) { float s0 = p0[r], s1 = p1[r]; s0 += __shfl_xor(s0, 8); s0 += __shfl_xor(s0, 16); s1 += __shfl_xor(s1, 8); s1 += __shfl_xor(s1, 16);
                if (head == 0 && rowok) { const int kk = crow(r, hi); Pq[qq * pq_pitch + tl * 64 + kk] = s0; Pq[qq * pq_pitch + tl * 64 + 32 + kk] = s1; } }
            bf16x8 pa0, pa1, pa2, pa3; p_to_frags(p0, p1, pa0, pa1, pa2, pa3);
            pv_d0(o, vb, pa0, pa1, pa2, pa3); }
    }
    if (wactive) flush_branch<0>(o, gate[0], OF, OBp, mbase, g, nq, wid, wsf, r32, hi);
    __syncthreads();
    const int nw = samp ? 5 : 1, nb = samp ? 257 : 64, nproc = ntc * 64;
    u64 myun[5] = {0ull, 0ull, 0ull, 0ull, 0ull};
    if (wactive) {
        for (int q2 = 0; q2 < 8; ++q2) {
            const int qq2 = wid * 8 + q2, t2 = t0 + qq2, cur = t2 >> 6;
            unsigned key[5]; bool vld[5];
#pragma unroll
            for (int w = 0; w < 5; ++w) { key[w] = 0u; vld[w] = false;
                if (w < nw) { const int jb = lane + 64 * w; float imp = 0.f;
#pragma unroll
                    for (int e = -1; e < 4; ++e) { const int c = 4 * jb + e; if (c >= 0 && c < nproc && jb < nb) imp += Pq[qq2 * pq_pitch + c]; }
                    const bool forced = (jb == 0) || (jb == cur) || (jb == cur - 1); vld[w] = (jb < nb) && (64 * jb <= t2);
                    const float val = vld[w] ? (forced ? imp + 1e4f : imp) : -1e30f; const unsigned bits = __float_as_uint(val);
                    key[w] = (jb < nb) ? ((bits & 0x80000000u) ? ~bits : (bits | 0x80000000u)) : 0u; } }
            unsigned T = 0u;
            for (int bit = 31; bit >= 0; --bit) { const unsigned cand = T | (1u << bit); int cnt = 0;
#pragma unroll
                for (int w = 0; w < 5; ++w) if (w < nw) cnt += __popcll(__ballot(key[w] >= cand));
                if (cnt >= 16) T = cand; }
            int ngt = 0;
#pragma unroll
            for (int w = 0; w < 5; ++w) if (w < nw) ngt += __popcll(__ballot(key[w] > T));
            int need = 16 - ngt, prev = 0;
#pragma unroll
            for (int w = 0; w < 5; ++w) if (w < nw) {
                const u64 eq = __ballot(key[w] == T); const int rank = prev + __popcll(eq & ((1ull << lane) - 1ull)); prev += __popcll(eq);
                const bool sel = (key[w] > T) || (key[w] == T && rank < need);
                const u64 mk = __ballot(sel && vld[w]);
                if (lane == 0) selm[qq2 * 5 + w] = mk;
                if (qq2 < nq) myun[w] |= mk; }
        }
    }
    if (lane == 0) {
#pragma unroll
        for (int w = 0; w < 5; ++w) if (w < nw) wun[wid * 5 + w] = myun[w]; }
    __syncthreads();
    float m_s = -1e30f, l_s = 0.f;
#pragma unroll
    for (int d = 0; d < 4; ++d) o[d] = (f32x16){};
    {
        const bf16_t* KS = (const bf16_t*)(ws + WS_KSEL) + (size_t)bg * SEQ * 128; const bf16_t* VS = (const bf16_t*)(ws + WS_VSEL) + (size_t)bg * SEQ * 128;
        const float* cache = (const float*)a.in[3]; const int* pt = (const int*)a.in[4] + b * 128;
        for (int w = 0; w < nw; ++w) {
            u64 U = 0ull;
#pragma unroll
            for (int x = 0; x < 8; ++x) U |= wun[x * 5 + w];
            unsigned ulo = __builtin_amdgcn_readfirstlane((unsigned)U), uhi = __builtin_amdgcn_readfirstlane((unsigned)(U >> 32));
            U = ((u64)uhi << 32) | ulo;
            const u64 mysel = rowok ? selm[qq * 5 + w] : 0ull;
            while (U) {
                const int bit = __builtin_ctzll(U); U &= U - 1ull; const int jb = 64 * w + bit;
                __syncthreads();
                if (!samp) stage_bf16(lds, KS + (size_t)jb * 64 * 128, VS + (size_t)jb * 64 * 128, true, tid);
                else if (jb < 256) stage_f32(lds, cache + ((size_t)pt[jb >> 1] * 128 + (jb & 1) * 64) * 1024 + g * 128, tid);
                else stage_bf16(lds, (const bf16_t*)(ws + WS_KSELNS) + (size_t)bg * 64 * 128, (const bf16_t*)(ws + WS_VSELNS) + (size_t)bg * 64 * 128, true, tid);
                __syncthreads();
                if (wactive) { f32x16 p0, p1; qkt(p0, p1, lds + L_K, qr, r32, hi);
                    mask_tile(p0, p1, tpos, 64 * jb, 1, 1 << 30, rowok && ((mysel >> bit) & 1ull), slope2, hi);
                    softmax_pv(p0, p1, m_s, l_s, o, vb, wsf, r32, hi); }
            }
        }
    }
    if (wactive) flush_branch<1>(o, l_s > 0.f ? gate[1] / l_s : 0.f, OF, OBp, mbase, g, nq, wid, wsf, r32, hi);
    float m_w = -1e30f, l_w = 0.f;
#pragma unroll
    for (int d = 0; d < 4; ++d) o[d] = (f32x16){};
    {
        const bf16_t* KW = samp ? (const bf16_t*)(ws + WS_KWINS) + (size_t)bg * 576 * 128 : (const bf16_t*)(ws + WS_KWIN) + (size_t)bg * SEQ * 128;
        const bf16_t* VW = samp ? (const bf16_t*)(ws + WS_VWINS) + (size_t)bg * 576 * 128 : (const bf16_t*)(ws + WS_VWIN) + (size_t)bg * SEQ * 128;
        const int jlo = samp ? 0 : (qt >= 8 ? qt - 8 : 0), jhi = samp ? 8 : qt, posb = samp ? PAST - 512 : 0;
        for (int jt = jlo; jt <= jhi; ++jt) {
            __syncthreads();
            stage_bf16(lds, KW + (size_t)jt * 64 * 128, VW + (size_t)jt * 64 * 128, true, tid);
            __syncthreads();
            if (wactive) { f32x16 p0, p1; qkt(p0, p1, lds + L_K, qr, r32, hi);
                mask_tile(p0, p1, tpos, posb + 64 * jt, 1, 512, rowok, slope2, hi);
                softmax_pv(p0, p1, m_w, l_w, o, vb, wsf, r32, hi); }
        }
    }
    if (wactive) flush_branch<2>(o, l_w > 0.f ? gate[2] / l_w : 0.f, OF, OBp, mbase, g, nq, wid, wsf, r32, hi);
    __syncthreads();
}

__device__ __forceinline__ void attn_phase(const Args& a, const Frame& F, int lj) {
    const int G = F.G;
    for (int rnd = 0; rnd * G < 512; ++rnd) {
        const int id = (rnd & 1) ? (rnd + 1) * G - 1 - F.vcu : rnd * G + F.vcu;
        if (id < 512) attn_unit(a, F, lj, false, (id >> 6) >> 2, (id >> 6) & 3, id & 63);
    }
    for (int us = F.vcu; us < 32; us += G) attn_unit(a, F, lj, true, us >> 2, us & 3, 0);
}
}

#ifndef PHMASK
#define PHMASK 0xFFFFFFFFu
#endif
#define PH(n) ((PHMASK >> (n)) & 1u)
__global__ void __launch_bounds__(NTHR, 2) mega_fwd(Args a) {
    extern __shared__ __attribute__((aligned(16))) unsigned char lds_raw[];
    Frame F; F.lds = (LAS unsigned char*)lds_raw; F.tid = threadIdx.x; F.lane = F.tid & 63; F.wave = __builtin_amdgcn_readfirstlane(F.tid >> 6);
    F.G = gridDim.x; { const int bx = blockIdx.x; F.vcu = (F.G % 8 == 0) ? (bx % 8) * (F.G / 8) + bx / 8 : bx; }
    unsigned char* ws = a.ws;
    volatile LAS unsigned* MISC = (volatile LAS unsigned*)(F.lds + MISC_OFF);
    for (int u = F.tid; u < (LDS_BYTES - LDSCTL_OFF) / 4; u += NTHR) ((LAS unsigned*)(F.lds + LDSCTL_OFF))[u] = 0u;
    __syncthreads();
    XcdBarrier bar = xcd_barrier_post((unsigned*)(ws + WS_CTL) + CW_BAR, MISC + 8);
    const int cblk = (int)blockIdx.x;
#define RELAUNDER() do { int t_ = threadIdx.x; asm volatile("" : "+v"(t_)); F.tid = t_; F.lane = t_ & 63; F.wave = __builtin_amdgcn_readfirstlane(t_ >> 6); asm volatile("" : "+s"(ws)); } while (0)

    RELAUNDER(); if (PH(0)) p0_prologue(a, F);
    xcd_barrier(bar);

    for (int l = 0; l < 4; ++l) {
        float* X = (float*)(ws + WS_X); bf16_t* XB = (bf16_t*)(ws + WS_XB);
        float* rowp_ffn = (float*)(ws + WS_ROWP + (size_t)(2 * l + 1) * ROWP_STRIDE);
        if (l < 2) {
            RELAUNDER(); if (PH(1)) pool_pass(a, F, l);
            xcd_barrier(bar);
            RELAUNDER(); if (PH(2)) { SchedMix S; S.o.init(NTM - 1, 8, F.G, cblk);
              EpiResid E{X, X, XB, rowp_ffn, (const float*)a.in[11] + l * D, MR};
              pg8::gemm_phase<EpiResid, SchedMix, true>(F.lds, (const char*)(ws + WS_POOLED), (const char*)(ws + WS_WPOOL) + (size_t)l * 4 * 512 * 512 * 2, D, 512, 512, S, E);
              for (int nb = F.vcu; nb < 32; nb += F.G) { const int g = nb >> 3;
                  mini_resid(F.lds, F.tid, (const bf16_t*)(ws + WS_POOLED) + (size_t)MP * D + g * 512, D, (const bf16_t*)(ws + WS_WPOOL) + ((size_t)(l * 4 + g) * 512 + (nb & 7) * 64) * 512, 512, 512, nb,
                             X, X, XB, rowp_ffn, (const float*)a.in[11] + l * D, MP); } }
            xcd_barrier(bar);
        } else {
            const int lj = l - 2;
            RELAUNDER(); if (PH(3)) { SchedPlain S; S.o.init(NTM, lj == 0 ? 21 : 9, F.G, cblk); S.astep = (size_t)256 * D * 2; S.bstep = (size_t)256 * D * 2;
              const float* rowp_mix = (const float*)(ws + WS_ROWP + (size_t)(2 * l) * ROWP_STRIDE);
              EpiF32 E{rowp_mix, lj == 0 ? (float*)(ws + WS_KV) : (float*)(ws + WS_QG), lj == 0 ? KVW : QGP, lj == 0 ? 12 : 1000, (float*)(ws + WS_QG), QGP};
              pg8::gemm_phase<EpiF32, SchedPlain, true>(F.lds, (const char*)XB, (const char*)(ws + (lj == 0 ? WS_WKVQG : WS_WQG1)), D, D, D, S, E); }
            xcd_barrier(bar);
            if (lj == 0) {
                RELAUNDER(); if (PH(4)) kvpost_pass(a, F);
                xcd_barrier(bar);
                RELAUNDER(); if (PH(5)) { SchedCmp S; S.o.init(CMP_ROWS / 256, 1, F.G, cblk);
                  EpiF32 E{nullptr, (float*)(ws + WS_PCMP), 256, 1000, nullptr, 0};
                  pg8::gemm_phase<EpiF32, SchedCmp, true>(F.lds, (const char*)(ws + WS_ACMP), (const char*)(ws + WS_W1CAT), 2048, 2048, 2048, S, E); }
                xcd_barrier(bar);
                RELAUNDER(); if (PH(6)) cmppost_pass(a, F);
                xcd_barrier(bar);
            }
            RELAUNDER(); if (PH(7)) nsa::attn_phase(a, F, lj);
            xcd_barrier(bar);
            RELAUNDER(); if (PH(8)) { SchedPlain S; S.o.init(NTM - 1, 8, F.G, cblk); S.astep = (size_t)256 * D * 2; S.bstep = (size_t)256 * D * 2;
              EpiResid E{X, X, XB, rowp_ffn, nullptr, MR};
              pg8::gemm_phase<EpiResid, SchedPlain, true>(F.lds, (const char*)(ws + WS_OB), (const char*)(ws + WS_WO) + (size_t)lj * D * D * 2, D, D, D, S, E);
              for (int nb = F.vcu; nb < 32; nb += F.G)
                  mini_resid(F.lds, F.tid, (const bf16_t*)(ws + WS_OB) + (size_t)MP * D, D, (const bf16_t*)(ws + WS_WO) + (size_t)lj * D * D + (size_t)nb * 64 * D, D, D, nb, X, X, XB, rowp_ffn, nullptr, MP); }
            xcd_barrier(bar);
        }
        RELAUNDER(); if (PH(9)) { SchedPlain S; S.o.init(NTM, 44, F.G, cblk); S.astep = (size_t)256 * D * 2; S.bstep = (size_t)256 * D * 2;
          EpiHH E{rowp_ffn, (bf16_t*)(ws + WS_HH), a.out + O_CONVP + (size_t)l * NBP * 2 * FF2, a.out + O_CONVS + (size_t)l * NBS * 2 * FF2};
          pg8::gemm_phase<EpiHH, SchedPlain, true>(F.lds, (const char*)XB, (const char*)(ws + WS_WIN) + (size_t)l * FF2 * D * 2, D, D, D, S, E); }
        xcd_barrier(bar);
        RELAUNDER(); if (PH(10)) convgate_pass(a, F, l);
        xcd_barrier(bar);
        RELAUNDER(); if (PH(11)) { SchedPlain S; S.o.init(NTM - 1, 8, F.G, cblk); S.astep = (size_t)256 * FF * 2; S.bstep = (size_t)256 * FF * 2;
          float* rowp_next = l < 3 ? (float*)(ws + WS_ROWP + (size_t)(2 * l + 2) * ROWP_STRIDE) : nullptr;
          EpiResid E{X, l < 3 ? X : a.out, l < 3 ? XB : nullptr, rowp_next, nullptr, MR};
          pg8::gemm_phase<EpiResid, SchedPlain, true>(F.lds, (const char*)(ws + WS_ACT), (const char*)(ws + WS_WOUT) + (size_t)l * D * FF * 2, FF, FF, FF, S, E);
          for (int nb = F.vcu; nb < 32; nb += F.G)
              mini_resid(F.lds, F.tid, (const bf16_t*)(ws + WS_ACT) + (size_t)MP * FF, FF, (const bf16_t*)(ws + WS_WOUT) + (size_t)l * D * FF + (size_t)nb * 64 * FF, FF, FF, nb,
                         X, l < 3 ? X : a.out, l < 3 ? XB : nullptr, rowp_next, nullptr, MP); }
        if (l < 3) xcd_barrier(bar);
    }
}

extern "C" void kernel_launch(void* const* d_in, const int* in_sizes, int n_in, void* d_out, int out_size, void* d_ws, size_t ws_size, hipStream_t stream) {
    static int grid = 0;
    if (grid == 0) {
        if (n_in != 25 || out_size != (int)O_END || ws_size < WS_END) { fprintf(stderr, "kernel_launch: unexpected shapes: n_in %d out %d ws %zu (need %zu)\n", n_in, out_size, ws_size, (size_t)WS_END); grid = -1; return; }
        int dev = 0, cus = 0, per_cu = 0;
        if (hipGetDevice(&dev) != hipSuccess || hipDeviceGetAttribute(&cus, hipDeviceAttributeMultiprocessorCount, dev) != hipSuccess) { grid = -1; return; }
        if (hipFuncSetAttribute((const void*)mega_fwd, hipFuncAttributeMaxDynamicSharedMemorySize, LDS_BYTES) != hipSuccess) { fprintf(stderr, "kernel_launch: hipFuncSetAttribute failed\n"); grid = -1; return; }
        if (hipOccupancyMaxActiveBlocksPerMultiprocessor(&per_cu, (const void*)mega_fwd, NTHR, LDS_BYTES) != hipSuccess || per_cu < 1) fprintf(stderr, "kernel_launch: occupancy query says %d\n", per_cu);
        (void)hipGetLastError();
        grid = cus;
    }
    if (grid < 0) return;
    (void)hipMemsetAsync((char*)d_ws + WS_CTL, 0, CTL_ZERO_BYTES, stream);
    Args a{};
    for (int i = 0; i < 25; ++i) a.in[i] = d_in[i];
    a.out = (float*)d_out; a.ws = (unsigned char*)d_ws;
    hipLaunchKernelGGL(mega_fwd, dim3(grid), dim3(NTHR), LDS_BYTES, stream, a);
    const hipError_t le = hipPeekAtLastError();
    if (le != hipSuccess) fprintf(stderr, "kernel_launch: launch failed: %s\n", hipGetErrorName(le));
}
```

```cpp
#include <hip/hip_runtime.h>
#include <cstdio>
#include <cstdint>

#define GAS __attribute__((address_space(1)))
#define LAS __attribute__((address_space(3)))
typedef unsigned short bf16_t;
typedef short bf16x8 __attribute__((ext_vector_type(8)));
typedef short s16x4 __attribute__((ext_vector_type(4)));
typedef float f32x2 __attribute__((ext_vector_type(2)));
typedef float f32x4 __attribute__((ext_vector_type(4)));
typedef float f32x8 __attribute__((ext_vector_type(8)));
typedef float f32x16 __attribute__((ext_vector_type(16)));
typedef unsigned u32x2 __attribute__((ext_vector_type(2)));
typedef unsigned u32x4 __attribute__((ext_vector_type(4)));
typedef unsigned long long u64;

constexpr int D = 2048, SEQ = 4096, NBP = 2, NBS = 8, TS = 8, PAST = 16384;
constexpr int MP = NBP * SEQ, MS = NBS * TS, MR = MP + MS, MPAD = 8448, NTM = MPAD / 256;
constexpr int FF = 5632, FF2 = 11264, NG = 4, HD = 128;
constexpr int KVW = 3072, QGW = 2096, QGP = 2304;
constexpr int NCP = 255, NCS = 1023;
constexpr float EPS = 1e-6f;
constexpr int NWAVES = 8, NTHR = 512;

constexpr size_t O_Y = 0, O_CMPP = 16908288, O_CMPS = 25296896, O_SELP = 25362432, O_SELS = 33751040, O_WINP = 33816576, O_WINS = 34865152,
                 O_POOLP = 39059456, O_POOLS = 39182336, O_CONVP = 39673856, O_CONVS = 39854080, O_END = 40574976;

constexpr size_t MiB = 1u << 20;
constexpr size_t WS_CTL = 0, CTL_ZERO_BYTES = 1 * MiB;
constexpr size_t WS_ROWP = 2 * MiB;
constexpr size_t ROWP_STRIDE = 2 * MiB;
constexpr size_t WS_WPOOL = 18 * MiB;
constexpr size_t WS_WIN = 22 * MiB;
constexpr size_t WS_WOUT = 198 * MiB;
constexpr size_t WS_WKVQG = 286 * MiB;
constexpr size_t WS_WQG1 = 307 * MiB;
constexpr size_t WS_WO = 316 * MiB;
constexpr size_t WS_W1CAT = 332 * MiB;
constexpr size_t WS_W2T = 334 * MiB;
constexpr size_t WS_CBIAS = 334 * MiB + 256 * 1024;
constexpr size_t WS_X = 335 * MiB;
constexpr size_t WS_XB = 401 * MiB;
constexpr size_t WS_POOLED = 434 * MiB;
constexpr size_t WS_HH = 467 * MiB;
constexpr size_t WS_ACT = 649 * MiB;
constexpr size_t WS_KV = 740 * MiB;
constexpr size_t WS_QG = 839 * MiB;
constexpr size_t WS_OB = 914 * MiB;
constexpr size_t WS_KSEL = 947 * MiB, WS_VSEL = 955 * MiB, WS_KWIN = 963 * MiB, WS_VWIN = 971 * MiB;
constexpr size_t WS_KCP = 979 * MiB, WS_VCP = 979 * MiB + 512 * 1024;
constexpr size_t WS_KCS = 980 * MiB, WS_VCS = 988 * MiB;
constexpr size_t WS_KWINS = 996 * MiB, WS_VWINS = 1001 * MiB;
constexpr size_t WS_KSELNS = 1006 * MiB, WS_VSELNS = 1006 * MiB + 512 * 1024;
constexpr size_t WS_ACMP = 1007 * MiB;
constexpr size_t WS_PCMP = 1279 * MiB;
constexpr size_t WS_OF32 = 1347 * MiB;
constexpr size_t WS_END = 1413 * MiB;
constexpr int CMP_ROWS = 69632, CMP_ROW_S0 = 4096;

constexpr int CW_TMO = 0, CW_BAR = 4096;

constexpr int RING_BYTES = 131072, LDSCTL_OFF = RING_BYTES, MISC_OFF = LDSCTL_OFF + 320, LDS_BYTES = 147456;

#define LDS_WAIT() asm volatile("s_waitcnt lgkmcnt(0)" ::: "memory")
#define VM_WAIT() asm volatile("s_waitcnt vmcnt(0)" ::: "memory")
#define SBAR() __builtin_amdgcn_sched_barrier(0)
__device__ __forceinline__ unsigned cvt_pk_bf16(float lo, float hi) { unsigned r; asm volatile("v_cvt_pk_bf16_f32 %0, %1, %2" : "=v"(r) : "v"(lo), "v"(hi)); return r; }
__device__ __forceinline__ float bf2f(bf16_t v) { return __uint_as_float((unsigned)v << 16); }
__device__ __forceinline__ float wave_sum(float v) {
#pragma unroll
    for (int o = 1; o < 64; o <<= 1) v += __shfl_xor(v, o);
    return v;
}

#define XB_TMO      128
#define XB_XCNT(j)  (256  + 64 * (j))
#define XB_XSUB(j)  (1280 + 64 * (j))
#define XB_XGEN(j)  (2304 + 64 * (j))
#define XB_TOP      3328
#define XB_TOPGEN   3392
#define XCD_BAR_WORDS 3456
#define XB_SPIN_CAP (1u << 18)
__device__ __forceinline__ unsigned xb_ld(unsigned* p)              { return __hip_atomic_load(p, __ATOMIC_RELAXED, __HIP_MEMORY_SCOPE_AGENT); }
__device__ __forceinline__ unsigned xb_add(unsigned* p, unsigned v) { return __hip_atomic_fetch_add(p, v, __ATOMIC_RELAXED, __HIP_MEMORY_SCOPE_AGENT); }
__device__ __forceinline__ unsigned xb_xcc_id() { return (unsigned)__builtin_amdgcn_s_getreg((3 << 11) | 20) & 0xFu; }
#define XB_SPIN(cond, bar) do { unsigned _sp = 0; while (cond) { __builtin_amdgcn_s_sleep(1); \
    if ((++_sp & 255u) == 0u) { if (xb_ld(&(bar)[XB_TMO])) break; if (_sp > XB_SPIN_CAP) { atomicAdd(&(bar)[XB_TMO], 1u); break; } } } } while (0)
struct XcdBarrier { unsigned* bar; unsigned x; volatile LAS unsigned* st; };
__device__ __forceinline__ XcdBarrier xcd_barrier_post(unsigned* bar, volatile LAS unsigned* st) {
    XcdBarrier b; b.bar = bar; b.x = xb_xcc_id(); b.st = st;
    if (threadIdx.x == 0) (void)xb_add(&bar[XB_XCNT(b.x)], 1u);
    return b;
}
__device__ __forceinline__ void xcd_barrier_complete(unsigned* bar, unsigned x, unsigned& nloc, unsigned& nx) {
    const unsigned G = gridDim.x * gridDim.y * gridDim.z;
    unsigned sum, cnt, mine, sp = 0u;
    for (;;) {
        sum = 0u; cnt = 0u; mine = 0u;
#pragma unroll
        for (unsigned j = 0; j < 16; ++j) { const unsigned c = xb_ld(&bar[XB_XCNT(j)]); sum += c; cnt += (c > 0u) ? 1u : 0u; mine = (j == x) ? c : mine; }
        if (sum == G) break;
        __builtin_amdgcn_s_sleep(1);
        if ((++sp & 255u) == 0u) { if (xb_ld(&bar[XB_TMO])) break; if (sp > XB_SPIN_CAP) { atomicAdd(&bar[XB_TMO], 1u); break; } }
    }
    nloc = mine > 0u ? mine : 1u; nx = cnt > 0u ? cnt : 1u;
}
__device__ __forceinline__ void xcd_barrier(const XcdBarrier& b) {
    asm volatile("s_waitcnt vmcnt(0)" ::: "memory");
    __syncthreads();
    if (threadIdx.x == 0) {
        unsigned* bar = b.bar; asm volatile("" : "+s"(bar));
        const unsigned bx_ = xb_xcc_id();
        __builtin_amdgcn_s_waitcnt(0);
        unsigned nloc = b.st[0], nx = b.st[1];
        if (nloc == 0u) { xcd_barrier_complete(bar, bx_, nloc, nx); b.st[0] = nloc; b.st[1] = nx; }
        const unsigned old = xb_add(&bar[XB_XSUB(bx_)], 1u);
        const unsigned gen = old / nloc;
        if (old + 1u == (gen + 1u) * nloc) {
            __builtin_amdgcn_fence(__ATOMIC_RELEASE, "agent");
            asm volatile("s_waitcnt vmcnt(0)" ::: "memory");
            const unsigned og = xb_add(&bar[XB_TOP], 1u);
            const unsigned tg = og / nx;
            if (og + 1u == (tg + 1u) * nx) xb_add(&bar[XB_TOPGEN], 1u);
            else XB_SPIN(xb_ld(&bar[XB_TOPGEN]) == tg, bar);
            __builtin_amdgcn_fence(__ATOMIC_ACQUIRE, "agent");
            xb_add(&bar[XB_XGEN(bx_)], 1u);
            asm volatile("s_waitcnt vmcnt(0)" ::: "memory");
        } else {
            XB_SPIN(xb_ld(&bar[XB_XGEN(bx_)]) == gen, bar);
            __builtin_amdgcn_fence(__ATOMIC_ACQUIRE, "agent");
            asm volatile("s_waitcnt vmcnt(0)" ::: "memory");
        }
    }
    __syncthreads();
}

namespace pg8 {
constexpr int BM = 256, BK = 64, HALF = 128, HTB = HALF * BK * 2, STAGE_BYTES = 8 * HTB, NXCD = 8, WGM = 8;
__host__ __device__ __forceinline__ int lds_byte(int r, int c) { const int st = (r >> 4) * 2 + (c >> 5), rr = r & 15, cc = c & 31, ob = rr * 64 + cc * 2; return st * 1024 + (ob ^ (((ob >> 9) & 1) << 5)); }
__host__ __device__ __forceinline__ void stage_rc(int b, int& R, int& C) { const int st = b / 1024, sb = b % 1024, swz = sb ^ (((sb >> 9) & 1) << 5); R = (st >> 1) * 16 + swz / 64; C = (st & 1) * 32 + (swz % 64) / 2; }
__host__ __device__ __forceinline__ int perm32(int rho) { const int n = rho >> 4, i = rho & 15; return 8 * (i >> 2) + 4 * n + (i & 3); }
struct Unit { int pm, pn; };
struct Order {
    int nM, nN, nwg, G, c;
    __device__ __forceinline__ void init(int nM_, int nN_, int G_, int c_) { nM = nM_; nN = nN_; nwg = nM * nN; G = G_; c = c_; }
    __device__ __forceinline__ bool next(int i, Unit& u) const {
        const long L = (long)i * G + c; if (L >= nwg) return false;
        int wgid = (int)L; { const int q = nwg / NXCD, r = nwg % NXCD, xcd = wgid % NXCD, off = wgid / NXCD; wgid = (xcd < r ? xcd * (q + 1) : r * (q + 1) + (xcd - r) * q) + off; }
        const int nig = WGM * nN, gid = wgid / nig, fm = gid * WGM, gsz = (nM - fm) < WGM ? (nM - fm) : WGM;
        u.pm = fm + ((wgid % nig) % gsz); u.pn = (wgid % nig) / gsz; return true;
    }
};
template <class Epi, class Sched, bool ALIGN_EPI>
__device__ __forceinline__ void gemm_phase(LAS unsigned char* lds, const char* Abase, const char* Bbase, int lda, int ldb, int K, const Sched& S, const Epi& E) {
    int tid = threadIdx.x; asm volatile("" : "+v"(tid));
    const int wid = __builtin_amdgcn_readfirstlane(tid >> 6), lane = tid & 63, wr = wid >> 2, wc = wid & 3, fr = lane & 15, fq = lane >> 4;
    const int nt = K / BK;
    unsigned voffA[2], voffB[2];
#pragma unroll
    for (int i = 0; i < 2; ++i) { int R, C; stage_rc(tid * 16 + i * 8192, R, C); const int Rb = Epi::PERM ? ((R & ~31) + perm32(R & 31)) : R;
        voffA[i] = (unsigned)(R * lda + C) * 2u; voffB[i] = (unsigned)(Rb * ldb + C) * 2u; }
    const size_t kstep = (size_t)(BK * 2);
    const size_t hstepA = (size_t)HALF * lda * 2, hstepB = (size_t)HALF * ldb * 2;
    const unsigned ldsw = (unsigned)wid * 1024u;
    const int aoff = lds_byte(wr * 64 + fr, fq * 8), boff = lds_byte(wc * 32 + fr, fq * 8);
#define PG8_SA(b, h) (((b) * 2 + (h)) * HTB)
#define PG8_SB(b, h) ((4 + (b) * 2 + (h)) * HTB)
#define PG8_STAGE(bufoff, gbase, voff) do { _Pragma("unroll") for (int _i = 0; _i < 2; ++_i) \
        __builtin_amdgcn_global_load_lds((const unsigned*)((const char*)(gbase) + (voff)[_i]), (LAS unsigned*)(lds + (bufoff) + ldsw + _i * 8192), 16, 0, 0); } while (0)
#define PG8_LDA(dst, b, h) do { _Pragma("unroll") for (int m = 0; m < 4; ++m) _Pragma("unroll") for (int k = 0; k < 2; ++k) dst[m][k] = *(const LAS bf16x8*)(lds + PG8_SA(b, h) + aoff + m * 2048 + k * 1024); } while (0)
#define PG8_LDB(dst, b, h) do { _Pragma("unroll") for (int n = 0; n < 2; ++n) _Pragma("unroll") for (int k = 0; k < 2; ++k) dst[n][k] = *(const LAS bf16x8*)(lds + PG8_SB(b, h) + boff + n * 2048 + k * 1024); } while (0)
#define PG8_MMA(ai, bj, At, Bt) do { __builtin_amdgcn_s_setprio(1); _Pragma("unroll") for (int m = 0; m < 4; ++m) _Pragma("unroll") for (int n = 0; n < 2; ++n) _Pragma("unroll") for (int k = 0; k < 2; ++k) \
        acc[ai][bj][m][n] = __builtin_amdgcn_mfma_f32_16x16x32_bf16(Bt[n][k], At[m][k], acc[ai][bj][m][n], 0, 0, 0); __builtin_amdgcn_s_setprio(0); } while (0)
#define PG8_WAIT_V(n) asm volatile("s_waitcnt vmcnt(" #n ")" ::: "memory")
#define PG8_WAIT_L(n) asm volatile("s_waitcnt lgkmcnt(" #n ")" ::: "memory")
#define PG8_BAR __builtin_amdgcn_s_barrier()
#define PG8_SCHED __builtin_amdgcn_sched_barrier(0)
    Unit cur, nxt; int ui = 0;
    if (!S.next(0, cur)) return;
    f32x4 acc[2][2][4][2];
#pragma unroll
    for (int a = 0; a < 2; ++a)
#pragma unroll
        for (int b = 0; b < 2; ++b)
#pragma unroll
            for (int m = 0; m < 4; ++m)
#pragma unroll
                for (int n = 0; n < 2; ++n) acc[a][b][m][n] = (f32x4){0.f, 0.f, 0.f, 0.f};
    bf16x8 At[4][2], B0[2][2], B1[2][2];
    const char* cA = Abase + S.aoff(cur); const char* cB = Bbase + S.boff(cur);
    PG8_STAGE(PG8_SB(0, 0), cB, voffB); PG8_STAGE(PG8_SB(0, 1), cB + hstepB, voffB); PG8_STAGE(PG8_SA(0, 0), cA, voffA); PG8_STAGE(PG8_SA(0, 1), cA + hstepA, voffA);
    if (wr == 1) PG8_BAR;
    PG8_WAIT_V(2); PG8_BAR;
    PG8_STAGE(PG8_SB(1, 0), cB + kstep, voffB); PG8_STAGE(PG8_SA(1, 0), cA + kstep, voffA); PG8_STAGE(PG8_SB(1, 1), cB + hstepB + kstep, voffB);
    PG8_WAIT_V(6); PG8_BAR;
    for (;;) {
        const bool has_next = S.next(ui + 1, nxt);
        const char* nA = has_next ? Abase + S.aoff(nxt) : cA; const char* nB = has_next ? Bbase + S.boff(nxt) : cB;
        for (int t = 0; t < nt; t += 2) {
            const bool last = (t == nt - 2);
            const char* a1 = cA + (size_t)(t + 1) * kstep;
            const char* a2 = last ? nA : cA + (size_t)(t + 2) * kstep; const char* b2 = last ? nB : cB + (size_t)(t + 2) * kstep;
            const char* a3 = a2 + kstep; const char* b3 = b2 + kstep;
            PG8_LDB(B0, 0, 0); PG8_LDB(B1, 0, 1); PG8_SCHED; PG8_LDA(At, 0, 0); PG8_STAGE(PG8_SA(1, 1), a1 + hstepA, voffA);
            PG8_WAIT_V(8); PG8_WAIT_L(0); PG8_BAR; PG8_MMA(0, 0, At, B0); PG8_MMA(0, 1, At, B1); PG8_BAR; PG8_SCHED;
            PG8_LDA(At, 0, 1); PG8_STAGE(PG8_SB(0, 0), b2, voffB); PG8_STAGE(PG8_SB(0, 1), b2 + hstepB, voffB); PG8_STAGE(PG8_SA(0, 0), a2, voffA);
            PG8_WAIT_V(8); PG8_WAIT_L(0); PG8_BAR; PG8_MMA(1, 0, At, B0); PG8_MMA(1, 1, At, B1); PG8_BAR; PG8_SCHED;
            PG8_LDB(B0, 1, 0); PG8_LDB(B1, 1, 1); PG8_SCHED; PG8_LDA(At, 1, 0); PG8_STAGE(PG8_SA(0, 1), a2 + hstepA, voffA);
            PG8_WAIT_V(8); PG8_WAIT_L(0); PG8_BAR; PG8_MMA(0, 0, At, B0); PG8_MMA(0, 1, At, B1); PG8_BAR; PG8_SCHED;
            PG8_LDA(At, 1, 1); PG8_STAGE(PG8_SB(1, 0), b3, voffB); PG8_STAGE(PG8_SB(1, 1), b3 + hstepB, voffB); PG8_STAGE(PG8_SA(1, 0), a3, voffA);
            PG8_WAIT_V(8); PG8_WAIT_L(0); PG8_BAR; PG8_MMA(1, 0, At, B0); PG8_MMA(1, 1, At, B1); PG8_BAR; PG8_SCHED;
        }
        if constexpr (ALIGN_EPI) { if (wr == 0) PG8_BAR; }
        { int fr_ = fr, fq_ = fq; asm volatile("" : "+v"(fr_), "+v"(fq_)); E(acc, cur, wr, wc, fr_, fq_); }
        if (!has_next) break;
#pragma unroll
        for (int a = 0; a < 2; ++a)
#pragma unroll
            for (int b = 0; b < 2; ++b)
#pragma unroll
                for (int m = 0; m < 4; ++m)
#pragma unroll
                    for (int n = 0; n < 2; ++n) acc[a][b][m][n] = (f32x4){0.f, 0.f, 0.f, 0.f};
        cur = nxt; cA = nA; cB = nB; ++ui;
        if constexpr (ALIGN_EPI) { if (wr == 1) PG8_BAR; }
    }
    PG8_WAIT_V(0);
    if constexpr (!ALIGN_EPI) { if (wr == 0) PG8_BAR; }
    PG8_BAR;
#undef PG8_SA
#undef PG8_SB
#undef PG8_STAGE
#undef PG8_LDA
#undef PG8_LDB
#undef PG8_MMA
#undef PG8_WAIT_V
#undef PG8_WAIT_L
#undef PG8_BAR
#undef PG8_SCHED
}
}
using pg8::Unit;

__device__ __forceinline__ float row_rstd(const float* rowp, int m) {
    const f32x4* p = (const f32x4*)(rowp + (size_t)m * 32); float s = 0.f;
#pragma unroll
    for (int i = 0; i < 8; ++i) { const f32x4 v = p[i]; s += (v[0] + v[1]) + (v[2] + v[3]); }
    return 1.0f / sqrtf(s * (1.0f / D) + EPS);
}

__device__ __forceinline__ float row_rstd4(const float* rowp, int m, int fq) {
    const f32x4* p = (const f32x4*)(rowp + (size_t)m * 32 + fq * 8); const f32x4 v0 = p[0], v1 = p[1];
    float s = ((v0[0] + v0[1]) + (v0[2] + v0[3])) + ((v1[0] + v1[1]) + (v1[2] + v1[3]));
    s += __shfl_xor(s, 16); s += __shfl_xor(s, 32);
    return 1.0f / sqrtf(s * (1.0f / D) + EPS);
}
struct SchedPlain {
    pg8::Order o; size_t astep, bstep;
    __device__ __forceinline__ bool next(int i, Unit& u) const { return o.next(i, u); }
    __device__ __forceinline__ size_t aoff(const Unit& u) const { return (size_t)u.pm * astep; }
    __device__ __forceinline__ size_t boff(const Unit& u) const { return (size_t)u.pn * bstep; }
};
struct SchedMix {
    pg8::Order o;
    __device__ __forceinline__ bool next(int i, Unit& u) const { return o.next(i, u); }
    __device__ __forceinline__ size_t aoff(const Unit& u) const { return ((size_t)u.pm * 256 * D + (size_t)(u.pn >> 1) * 512) * 2; }
    __device__ __forceinline__ size_t boff(const Unit& u) const { return ((size_t)(u.pn >> 1) * 512 * 512 + (size_t)(u.pn & 1) * 256 * 512) * 2; }
};
struct SchedCmp {
    pg8::Order o;
    __device__ __forceinline__ bool next(int i, Unit& u) const { return o.next(i, u); }
    __device__ __forceinline__ size_t aoff(const Unit& u) const { return (size_t)u.pm * 256 * 2048 * 2; }
    __device__ __forceinline__ size_t boff(const Unit& u) const { const int v = (u.pm < 8) ? 0 : (u.pm < 16) ? 1 : (u.pm < 144) ? 0 : 1; return (size_t)v * 256 * 2048 * 2; }
};

struct EpiResid {
    static constexpr bool PERM = false;
    const float* xin; float* xout; bf16_t* xb; float* rowp; const float* colscale; int mlimit;
    __device__ __forceinline__ void operator()(const f32x4 (&acc)[2][2][4][2], const Unit& u, int wr, int wc, int fr, int fq) const {
        const int col0 = u.pn * 256 + wc * 32 + 4 * fq;
        f32x4 cs[2][2];
#pragma unroll
        for (int bj = 0; bj < 2; ++bj)
#pragma unroll
            for (int n = 0; n < 2; ++n) cs[bj][n] = colscale ? *(const f32x4*)(colscale + col0 + bj * 128 + n * 16) : (f32x4){1.f, 1.f, 1.f, 1.f};
#pragma unroll
        for (int ai = 0; ai < 2; ++ai)
#pragma unroll
            for (int m = 0; m < 4; ++m) {
                const int row = u.pm * 256 + ai * 128 + wr * 64 + m * 16 + fr; const size_t off = (size_t)row * D + col0; float ss = 0.f;
                const bool ok = row < mlimit;
#pragma unroll
                for (int bj = 0; bj < 2; ++bj)
#pragma unroll
                    for (int n = 0; n < 2; ++n) {
                        f32x4 b = ok ? *(const f32x4*)(xin + off + bj * 128 + n * 16) : (f32x4){0.f, 0.f, 0.f, 0.f};
                        const f32x4 v = b + acc[ai][bj][m][n] * cs[bj][n];
                        ss += (v[0] * v[0] + v[1] * v[1]) + (v[2] * v[2] + v[3] * v[3]);
                        if (ok) { *(f32x4*)(xout + off + bj * 128 + n * 16) = v;
                            if (xb) { u32x2 w; w.x = cvt_pk_bf16(v[0], v[1]); w.y = cvt_pk_bf16(v[2], v[3]); *(u32x2*)(xb + off + bj * 128 + n * 16) = w; } }
                    }
                ss += __shfl_xor(ss, 16); ss += __shfl_xor(ss, 32);
                if (rowp && fq == 0 && ok) rowp[(size_t)row * 32 + u.pn * 4 + wc] = ss;
                if (m & 1) asm volatile("" ::: "memory");
            }
    }
};
struct EpiF32 {
    static constexpr bool PERM = false;
    const float* rowp; float* out; int ldo; int split; float* out2; int ldo2;
    __device__ __forceinline__ void operator()(const f32x4 (&acc)[2][2][4][2], const Unit& u, int wr, int wc, int fr, int fq) const {
        float* o = out; int ld = ldo; int pn = u.pn; if (pn >= split) { o = out2; ld = ldo2; pn -= split; }
        const int col0 = pn * 256 + wc * 32 + 4 * fq;
#pragma unroll
        for (int ai = 0; ai < 2; ++ai)
#pragma unroll
            for (int m = 0; m < 4; ++m) {
                const int row = u.pm * 256 + ai * 128 + wr * 64 + m * 16 + fr; const float rs = rowp ? row_rstd4(rowp, row, fq) : 1.0f; const size_t off = (size_t)row * ld + col0;
#pragma unroll
                for (int bj = 0; bj < 2; ++bj)
#pragma unroll
                    for (int n = 0; n < 2; ++n) *(f32x4*)(o + off + bj * 128 + n * 16) = acc[ai][bj][m][n] * rs;
            }
    }
};
struct EpiHH {
    static constexpr bool PERM = true;
    const float* rowp; bf16_t* hh; float* convp; float* convs;
    __device__ __forceinline__ void operator()(const f32x4 (&acc)[2][2][4][2], const Unit& u, int wr, int wc, int fr, int fq) const {
        const int colt = wc * 32 + 8 * fq;
#pragma unroll
        for (int ai = 0; ai < 2; ++ai)
#pragma unroll
            for (int m = 0; m < 4; ++m) {
                const int trow = ai * 128 + wr * 64 + m * 16 + fr, row = u.pm * 256 + trow; const float rs = row_rstd4(rowp, row, fq);
                bf16_t* rowptr = hh + (size_t)row * FF2 + u.pn * 256 + colt;
                float* cdst = nullptr;
                if (u.pm == 32) { if (trow < 64 && (trow & 7) >= 6) cdst = convs + ((size_t)(trow >> 3) * 2 + ((trow & 7) - 6)) * FF2; }
                else if ((u.pm & 15) == 15 && trow >= 254) cdst = convp + ((size_t)(u.pm >> 4) * 2 + (trow - 254)) * FF2;
#pragma unroll
                for (int bj = 0; bj < 2; ++bj) {
                    const f32x4 v0 = acc[ai][bj][m][0] * rs, v1 = acc[ai][bj][m][1] * rs;
                    u32x4 w; w.x = cvt_pk_bf16(v0[0], v0[1]); w.y = cvt_pk_bf16(v0[2], v0[3]); w.z = cvt_pk_bf16(v1[0], v1[1]); w.w = cvt_pk_bf16(v1[2], v1[3]);
                    *(u32x4*)(rowptr + bj * 128) = w;
                    if (cdst) { float* c = cdst + bj * FF + u.pn * 128 + colt; *(f32x4*)c = v0; *(f32x4*)(c + 4) = v1; }
                }
            }
    }
};


__device__ __forceinline__ void mini_resid(LAS unsigned char* lds, int tid_in, const bf16_t* A, int lda, const bf16_t* Bt, int ldb, int K, int nb,
                                           const float* xin, float* xout, bf16_t* xb, float* rowp, const float* colscale, int row0) {
    int tid = tid_in; asm volatile("" : "+v"(tid));
    const int wid = __builtin_amdgcn_readfirstlane(tid >> 6), lane = tid & 63, fr = lane & 15, fq = lane >> 4;
    const int kw = K >> 3, kbeg = wid * kw;
    f32x4 acc[4][4];
#pragma unroll
    for (int i = 0; i < 4; ++i)
#pragma unroll
        for (int j = 0; j < 4; ++j) acc[i][j] = (f32x4){0.f, 0.f, 0.f, 0.f};
    const bf16_t* ap = A + (size_t)fr * lda + kbeg + fq * 8; const bf16_t* bp = Bt + (size_t)fr * ldb + kbeg + fq * 8;
#define MINI_STEPS(CH, kk) do { bf16x8 af[CH][4], bf[CH][4]; \
        _Pragma("unroll") for (int c = 0; c < CH; ++c) _Pragma("unroll") for (int i = 0; i < 4; ++i) { af[c][i] = *(const bf16x8*)(ap + (size_t)(16 * i) * lda + (kk) + 32 * c); bf[c][i] = *(const bf16x8*)(bp + (size_t)(16 * i) * ldb + (kk) + 32 * c); } \
        _Pragma("unroll") for (int c = 0; c < CH; ++c) _Pragma("unroll") for (int i = 0; i < 4; ++i) _Pragma("unroll") for (int j = 0; j < 4; ++j) \
            acc[i][j] = __builtin_amdgcn_mfma_f32_16x16x32_bf16(bf[c][j], af[c][i], acc[i][j], 0, 0, 0); } while (0)
    int k = 0;
    for (; k + 128 <= kw; k += 128) MINI_STEPS(4, k);
    for (; k + 64 <= kw; k += 64) MINI_STEPS(2, k);
    for (; k < kw; k += 32) MINI_STEPS(1, k);
#undef MINI_STEPS
    __syncthreads();
    LAS float* part = (LAS float*)lds + wid * 4096;
#pragma unroll
    for (int i = 0; i < 4; ++i)
#pragma unroll
        for (int j = 0; j < 4; ++j) *(LAS f32x4*)(part + (16 * i + fr) * 64 + 16 * j + 4 * fq) = acc[i][j];
    __syncthreads();
    const int row = wid * 8 + (lane >> 3), c8 = (lane & 7) * 8;
    f32x4 s0 = {0.f, 0.f, 0.f, 0.f}, s1 = {0.f, 0.f, 0.f, 0.f};
#pragma unroll
    for (int w = 0; w < 8; ++w) { const LAS float* p = (const LAS float*)lds + w * 4096 + row * 64 + c8; s0 += *(const LAS f32x4*)p; s1 += *(const LAS f32x4*)(p + 4); }
    const int col = nb * 64 + c8; const size_t off = (size_t)(row0 + row) * D + col;
    if (colscale) { s0 = s0 * *(const f32x4*)(colscale + col); s1 = s1 * *(const f32x4*)(colscale + col + 4); }
    const f32x4 v0 = *(const f32x4*)(xin + off) + s0, v1 = *(const f32x4*)(xin + off + 4) + s1;
    *(f32x4*)(xout + off) = v0; *(f32x4*)(xout + off + 4) = v1;
    if (xb) { u32x4 w; w.x = cvt_pk_bf16(v0[0], v0[1]); w.y = cvt_pk_bf16(v0[2], v0[3]); w.z = cvt_pk_bf16(v1[0], v1[1]); w.w = cvt_pk_bf16(v1[2], v1[3]); *(u32x4*)(xb + off) = w; }
    float ss = ((v0[0] * v0[0] + v0[1] * v0[1]) + (v0[2] * v0[2] + v0[3] * v0[3])) + ((v1[0] * v1[0] + v1[1] * v1[1]) + (v1[2] * v1[2] + v1[3] * v1[3]));
    ss += __shfl_xor(ss, 1); ss += __shfl_xor(ss, 2); ss += __shfl_xor(ss, 4);
    if (rowp && (lane & 7) == 0) rowp[(size_t)(row0 + row) * 32 + nb] = ss;
    __syncthreads();
}

struct Args { const void* in[25]; float* out; unsigned char* ws; };
struct Frame {
    LAS unsigned char* lds; int tid, lane, wave, vcu, G;
};

__device__ __forceinline__ void tr_item(const float* W, int ldw, int k0, int nsrc0, int nvalid, const float* kscale, bf16_t* WT, int ldt, int ndst0, LAS float* scr, int lane) {
    const int r = lane >> 4, c4 = (lane & 15) * 4; const bool cv = nsrc0 + c4 < nvalid;
    f32x4 v[16];
#pragma unroll
    for (int i = 0; i < 16; ++i) v[i] = cv ? *(const f32x4*)(W + (size_t)(k0 + 4 * i + r) * ldw + nsrc0 + c4) : (f32x4){0.f, 0.f, 0.f, 0.f};
    if (kscale) {
#pragma unroll
        for (int i = 0; i < 16; ++i) v[i] = v[i] * kscale[k0 + 4 * i + r]; }
#pragma unroll
    for (int i = 0; i < 16; ++i) *(LAS f32x4*)(scr + (4 * i + r) * 64 + c4) = v[i];
    LDS_WAIT(); asm volatile("" ::: "memory");
    bf16_t* dst = WT + (size_t)(ndst0 + lane) * ldt + k0;
#pragma unroll
    for (int j = 0; j < 8; ++j) { const LAS float* p = scr + (8 * j) * 64 + lane;
        u32x4 o; o.x = cvt_pk_bf16(p[0], p[64]); o.y = cvt_pk_bf16(p[128], p[192]); o.z = cvt_pk_bf16(p[256], p[320]); o.w = cvt_pk_bf16(p[384], p[448]);
        *(u32x4*)(dst + 8 * j) = o; }
    LDS_WAIT(); asm volatile("" ::: "memory");
}

__device__ __forceinline__ void p0_prologue(const Args& a, const Frame& F) {
    unsigned char* ws = a.ws;
    LAS float* scr = (LAS float*)(F.lds + F.wave * 16384);
    const int gw = F.vcu * NWAVES + F.wave, NGW = F.G * NWAVES, lane = F.lane;
    const float* ln_mix = (const float*)a.in[8]; const float* ln_ffn = (const float*)a.in[9];
    constexpr int I_POOL = 8 * 8 * 8, I_WIN = 32 * 176, I_WOUT = 88 * 32, I_WKV = 32 * 48, I_WQG = 32 * 36, I_WO = 32 * 32, I_W1 = 32 * 2, I_W2 = 2 * 2;
    constexpr int NITEMS = I_POOL + 4 * I_WIN + 4 * I_WOUT + I_WKV + 2 * I_WQG + 2 * I_WO + 4 * I_W1 + 2 * I_W2;
    for (int it = gw; it < NITEMS; it += NGW) {
        int r = it;
        if (r < I_POOL) { const int mat = r >> 6, q = r & 63, kb = q >> 3, nb = q & 7;
            tr_item((const float*)a.in[10] + (size_t)mat * 512 * 512, 512, kb * 64, nb * 64, 512, nullptr, (bf16_t*)(ws + WS_WPOOL) + (size_t)mat * 512 * 512, 512, nb * 64, scr, lane); continue; } r -= I_POOL;
        if (r < 4 * I_WIN) { const int l = r / I_WIN, q = r % I_WIN, kb = q / 176, nb = q % 176; const int ns = nb * 64;
            const int f = ns < FF ? ns : ns - FF; const int nd = (f >> 7) * 256 + (ns < FF ? 0 : 128) + (f & 127);
            tr_item((const float*)a.in[21] + (size_t)l * D * FF2, FF2, kb * 64, ns, FF2, ln_ffn + l * D, (bf16_t*)(ws + WS_WIN) + (size_t)l * FF2 * D, D, nd, scr, lane); continue; } r -= 4 * I_WIN;
        if (r < 4 * I_WOUT) { const int l = r / I_WOUT, q = r % I_WOUT, kb = q >> 5, nb = q & 31;
            tr_item((const float*)a.in[24] + (size_t)l * FF * D, D, kb * 64, nb * 64, D, nullptr, (bf16_t*)(ws + WS_WOUT) + (size_t)l * D * FF, FF, nb * 64, scr, lane); continue; } r -= 4 * I_WOUT;
        if (r < I_WKV) { const int kb = r / 48, nb = r % 48;
            tr_item((const float*)a.in[13], KVW, kb * 64, nb * 64, KVW, (const float*)a.in[12], (bf16_t*)(ws + WS_WKVQG), D, nb * 64, scr, lane); continue; } r -= I_WKV;
        if (r < 2 * I_WQG) { const int j = r / I_WQG, q = r % I_WQG, kb = q / 36, nb = q % 36;
            bf16_t* dst = j == 0 ? (bf16_t*)(ws + WS_WKVQG) + (size_t)KVW * D : (bf16_t*)(ws + WS_WQG1);
            tr_item((const float*)a.in[18] + (size_t)j * D * QGW, QGW, kb * 64, nb * 64, QGW, ln_mix + (2 + j) * D, dst, D, nb * 64, scr, lane); continue; } r -= 2 * I_WQG;
        if (r < 2 * I_WO) { const int j = r / I_WO, q = r % I_WO, kb = q >> 5, nb = q & 31;
            tr_item((const float*)a.in[20] + (size_t)j * D * D, D, kb * 64, nb * 64, D, nullptr, (bf16_t*)(ws + WS_WO) + (size_t)j * D * D, D, nb * 64, scr, lane); continue; } r -= 2 * I_WO;
        if (r < 4 * I_W1) { const int vh = r / I_W1, q = r % I_W1, kb = q >> 1, nb = q & 1; const int v = vh >> 1, half = vh & 1;
            tr_item((const float*)a.in[15] + ((size_t)(v * 32 + half * 16) * 128) * 128, 128, kb * 64, nb * 64, 128, nullptr, (bf16_t*)(ws + WS_W1CAT) + (size_t)v * 256 * 2048, 2048, half * 128 + nb * 64, scr, lane); continue; } r -= 4 * I_W1;
        { const int v = r / I_W2, q = r % I_W2, kb = q >> 1, nb = q & 1;
            tr_item((const float*)a.in[17] + (size_t)v * 128 * 128, 128, kb * 64, nb * 64, 128, nullptr, (bf16_t*)(ws + WS_W2T) + (size_t)v * 128 * 128, 128, nb * 64, scr, lane); }
    }
    for (int it = gw; it < 256; it += NGW) { const int v = it >> 7, h = it & 127; const float* pos = (const float*)a.in[16] + (size_t)v * 4096; const float* w1 = (const float*)a.in[15] + (size_t)v * 4096 * 128 + h;
        float s = 0.f; for (int i = lane; i < 4096; i += 64) s += pos[i] * w1[(size_t)i * 128];
        s = wave_sum(s); if (lane == 0) ((float*)(ws + WS_CBIAS))[it] = s; }
    { float* X = (float*)(ws + WS_X); float* rowp = (float*)(ws + WS_ROWP);
      for (int m = gw; m < MR; m += NGW) { const float* src = m < MP ? (const float*)a.in[0] + (size_t)m * D : (const float*)a.in[1] + (size_t)(m - MP) * D;
          float s = 0.f;
#pragma unroll
          for (int j = 0; j < 8; ++j) { const f32x4 v = *((const f32x4*)src + lane + 64 * j); *((f32x4*)(X + (size_t)m * D) + lane + 64 * j) = v; s += (v[0] * v[0] + v[1] * v[1]) + (v[2] * v[2] + v[3] * v[3]); }
          s = wave_sum(s); if (lane < 32) rowp[(size_t)m * 32 + lane] = lane == 0 ? s : 0.f; } }
    { const float* cache = (const float*)a.in[2]; const int* pt = (const int*)a.in[4]; bf16_t* ACMP = (bf16_t*)(ws + WS_ACMP);
      for (int it = gw; it < NBS * 1024; it += NGW) { const int b = it >> 10, n = it & 1023; const int page = pt[b * 128 + (n >> 3)];
          const float* src = cache + ((size_t)page * 128 + (n & 7) * 16) * 1024;
#pragma unroll 8
          for (int s = 0; s < 16; ++s)
#pragma unroll
              for (int q = 0; q < 4; ++q) { const f32x4 v = __builtin_nontemporal_load((const f32x4*)(src + s * 1024 + q * 256) + lane); const int hq = q * 2 + (lane >> 5), vv = hq >> 2, g = hq & 3, d = (lane & 31) * 4;
                  u32x2 w; w.x = cvt_pk_bf16(v[0], v[1]); w.y = cvt_pk_bf16(v[2], v[3]);
                  *(u32x2*)(ACMP + ((size_t)CMP_ROW_S0 + (size_t)vv * 32768 + (size_t)(b * 4 + g) * 1024 + n) * 2048 + s * 128 + d) = w; } } }
    { const float* st = (const float*)a.in[5]; bf16_t* KW = (bf16_t*)(ws + WS_KWINS); bf16_t* VW = (bf16_t*)(ws + WS_VWINS); float* ow = a.out + O_WINS;
      for (int it = gw; it < NBS * 512; it += NGW) { const int b = it >> 9, i = it & 511; const float* src = st + (size_t)it * 1024;
#pragma unroll
          for (int q = 0; q < 4; ++q) { const f32x4 v = *((const f32x4*)(src + q * 256) + lane); const int hq = q * 2 + (lane >> 5), vv = hq >> 2, g = hq & 3, d = (lane & 31) * 4;
              u32x2 w; w.x = cvt_pk_bf16(v[0], v[1]); w.y = cvt_pk_bf16(v[2], v[3]);
              *(u32x2*)((vv ? VW : KW) + ((size_t)(b * 4 + g) * 576 + i) * 128 + d) = w;
              if (i >= 8) *((f32x4*)(ow + ((size_t)b * 512 + (i - 8)) * 1024 + q * 256) + lane) = v; } } }
    { const int gt = gw * 64 + lane, NGT = NGW * 64; const u32x4 z = {0u, 0u, 0u, 0u};
      for (int i = gt; i < (int)(MiB / 16); i += NGT) { *((u32x4*)(ws + WS_KCP) + i) = z; *((u32x4*)(ws + WS_KSELNS) + i) = z; }
      for (int i = gt; i < 32 * 16; i += NGT) { const int bg = i >> 4, c = i & 15; *((u32x4*)(ws + WS_KCS + ((size_t)bg * 1024 + 1023) * 256) + c) = z; *((u32x4*)(ws + WS_VCS + ((size_t)bg * 1024 + 1023) * 256) + c) = z; }
      for (int i = gt; i < 32 * 56 * 16; i += NGT) { const int bg = i / (56 * 16), r = i % (56 * 16); *((u32x4*)(ws + WS_KWINS + ((size_t)bg * 576 + 520) * 256) + r) = z; *((u32x4*)(ws + WS_VWINS + ((size_t)bg * 576 + 520) * 256) + r) = z; } }
}

__device__ __forceinline__ void pool_pass(const Args& a, const Frame& F, int l) {
    unsigned char* ws = a.ws; const float* X = (const float*)(ws + WS_X); const float* rowp = (const float*)(ws + WS_ROWP + (size_t)(2 * l) * ROWP_STRIDE);
    const float* gain = (const float*)a.in[8] + l * D; bf16_t* PO = (bf16_t*)(ws + WS_POOLED);
    LAS float* ctx = (LAS float*)F.lds; LAS float* rs = (LAS float*)(F.lds + 47 * 512 * 4);
    const int tid = F.tid;
    constexpr int NUP = (MP / 32) * 4, NU = NUP + NBS * 4;
    for (int u = F.vcu; u < NU; u += F.G) {
        __syncthreads();
        if (u < NUP) {
            const int g = u & 3, rt = u >> 2, b = rt >> 7, t0 = (rt & 127) * 32, w = 2 << g;
            if (tid < 47) { const int t = t0 - 15 + tid; rs[tid] = t >= 0 ? row_rstd(rowp, b * SEQ + t) : 0.f; }
            __syncthreads();
            { const int c4 = tid & 127; const f32x4 gv = *((const f32x4*)(gain + g * 512) + c4);
              for (int r = tid >> 7; r < 47; r += 4) { const int t = t0 - 15 + r; f32x4 v = {0.f, 0.f, 0.f, 0.f};
                  if (t >= 0) { v = *((const f32x4*)(X + (size_t)(b * SEQ + t) * D + g * 512) + c4); v = v * rs[r] * gv; }
                  *((LAS f32x4*)(ctx + r * 512) + c4) = v; } }
            __syncthreads();
            { const int cp = tid & 255, half = tid >> 8, r0 = 15 + half * 16; float s0 = 0.f, s1 = 0.f;
              for (int i = 1; i < w; ++i) { const f32x2 v = *(const LAS f32x2*)(ctx + (r0 - i) * 512 + 2 * cp); s0 += v[0]; s1 += v[1]; }
              for (int i = 0; i < 16; ++i) { const int r = r0 + i, t = t0 + half * 16 + i; const f32x2 h = *(const LAS f32x2*)(ctx + r * 512 + 2 * cp); s0 += h[0]; s1 += h[1];
                  const float inv = 1.0f / (float)(t + 1 < w ? t + 1 : w);
                  *(unsigned*)(PO + (size_t)(b * SEQ + t) * D + g * 512 + 2 * cp) = cvt_pk_bf16(s0 * inv - h[0], s1 * inv - h[1]);
                  const f32x2 o = *(const LAS f32x2*)(ctx + (r - w + 1) * 512 + 2 * cp); s0 -= o[0]; s1 -= o[1]; } }
            if (t0 == SEQ - 32) { float* op = a.out + O_POOLP + ((size_t)(l * NBP + b) * 15) * D + g * 512;
                for (int i = tid; i < 15 * 512; i += NTHR) { const int r = i >> 9, c = i & 511; op[(size_t)r * D + c] = ctx[(32 + r) * 512 + c]; } }
        } else {
            const int us = u - NUP, g = us & 3, b = us >> 2, w = 2 << g; const float* sp = (const float*)a.in[6] + ((size_t)(l * NBS + b) * 15) * D + g * 512;
            if (tid < 8) rs[tid] = row_rstd(rowp, MP + b * 8 + tid);
            __syncthreads();
            for (int i = tid; i < 23 * 512; i += NTHR) { const int r = i >> 9, c = i & 511;
                ctx[i] = r < 15 ? sp[(size_t)r * D + c] : X[(size_t)(MP + b * 8 + r - 15) * D + g * 512 + c] * rs[r - 15] * gain[g * 512 + c]; }
            __syncthreads();
            { const int c = tid; const float inv = 1.0f / (float)w;
              for (int t = 0; t < 8; ++t) { float s = 0.f; for (int i = 0; i < w; ++i) s += ctx[(15 + t - i) * 512 + c];
                  PO[(size_t)(MP + b * 8 + t) * D + g * 512 + c] = (bf16_t)(cvt_pk_bf16(s * inv - ctx[(15 + t) * 512 + c], 0.f) & 0xffffu); } }
            { float* op = a.out + O_POOLS + ((size_t)(l * NBS + b) * 15) * D + g * 512;
              for (int i = tid; i < 15 * 512; i += NTHR) { const int r = i >> 9, c = i & 511; op[(size_t)r * D + c] = ctx[(8 + r) * 512 + c]; } }
        }
    }
    __syncthreads();
}

__device__ __forceinline__ void convgate_pass(const Args& a, const Frame& F, int l) {
    unsigned char* ws = a.ws; const bf16_t* HH = (const bf16_t*)(ws + WS_HH); bf16_t* ACT = (bf16_t*)(ws + WS_ACT);
    const float* cw = (const float*)a.in[22] + (size_t)l * 3 * FF2; const float* cb = (const float*)a.in[23] + (size_t)l * FF2; const float* sc = (const float*)a.in[7] + (size_t)l * NBS * 2 * FF2;
    const int gw = F.vcu * NWAVES + F.wave, NGW = F.G * NWAVES, lane = F.lane;
    constexpr int NCH_P = MP / 16, NIT = (NCH_P + NBS) * 11;
    for (int it = gw; it < NIT; it += NGW) {
        const int fg = it % 11, ch = it / 11; const int f0 = fg * 512 + lane * 8, pn = f0 >> 7, j0 = f0 & 127;
        const bool samp = ch >= NCH_P; const int bs = ch - NCH_P; const int m0 = samp ? MP + bs * 8 : ch * 16, nrow = samp ? 8 : 16; const bool seq_start = samp || ((ch & 255) == 0);
        float wg[3][8], wv[3][8], bg[8], bv[8];
#pragma unroll
        for (int k = 0; k < 3; ++k) { const f32x4 a0 = *(const f32x4*)(cw + k * FF2 + f0), a1 = *(const f32x4*)(cw + k * FF2 + f0 + 4), c0 = *(const f32x4*)(cw + k * FF2 + FF + f0), c1 = *(const f32x4*)(cw + k * FF2 + FF + f0 + 4);
#pragma unroll
            for (int i = 0; i < 4; ++i) { wg[k][i] = a0[i]; wg[k][4 + i] = a1[i]; wv[k][i] = c0[i]; wv[k][4 + i] = c1[i]; } }
        { const f32x4 a0 = *(const f32x4*)(cb + f0), a1 = *(const f32x4*)(cb + f0 + 4), c0 = *(const f32x4*)(cb + FF + f0), c1 = *(const f32x4*)(cb + FF + f0 + 4);
#pragma unroll
          for (int i = 0; i < 4; ++i) { bg[i] = a0[i]; bg[4 + i] = a1[i]; bv[i] = c0[i]; bv[4 + i] = c1[i]; } }
        float g2[8], g1[8], v2[8], v1[8];
        const size_t colg = (size_t)pn * 256 + j0;
        if (seq_start) {
            if (samp) { const float* p0 = sc + ((size_t)bs * 2 + 0) * FF2, *p1 = sc + ((size_t)bs * 2 + 1) * FF2;
#pragma unroll
                for (int i = 0; i < 8; ++i) { g2[i] = p0[f0 + i]; v2[i] = p0[FF + f0 + i]; g1[i] = p1[f0 + i]; v1[i] = p1[FF + f0 + i]; } }
            else {
#pragma unroll
                for (int i = 0; i < 8; ++i) { g2[i] = 0.f; g1[i] = 0.f; v2[i] = 0.f; v1[i] = 0.f; } }
        } else {
            const bf16x8 a2 = *(const bf16x8*)(HH + (size_t)(m0 - 2) * FF2 + colg), a1 = *(const bf16x8*)(HH + (size_t)(m0 - 1) * FF2 + colg);
            const bf16x8 c2 = *(const bf16x8*)(HH + (size_t)(m0 - 2) * FF2 + colg + 128), c1 = *(const bf16x8*)(HH + (size_t)(m0 - 1) * FF2 + colg + 128);
#pragma unroll
            for (int i = 0; i < 8; ++i) { g2[i] = bf2f((bf16_t)a2[i]); g1[i] = bf2f((bf16_t)a1[i]); v2[i] = bf2f((bf16_t)c2[i]); v1[i] = bf2f((bf16_t)c1[i]); }
        }
        for (int r = 0; r < nrow; ++r) {
            const bf16x8 ag = *(const bf16x8*)(HH + (size_t)(m0 + r) * FF2 + colg), av = *(const bf16x8*)(HH + (size_t)(m0 + r) * FF2 + colg + 128);
            float o[8];
#pragma unroll
            for (int i = 0; i < 8; ++i) { const float hg = bf2f((bf16_t)ag[i]), hv = bf2f((bf16_t)av[i]);
                const float cg = bg[i] + wg[0][i] * g2[i] + wg[1][i] * g1[i] + wg[2][i] * hg, cv = bv[i] + wv[0][i] * v2[i] + wv[1][i] * v1[i] + wv[2][i] * hv;
                o[i] = cg / (1.0f + __expf(-cg)) * cv; g2[i] = g1[i]; g1[i] = hg; v2[i] = v1[i]; v1[i] = hv; }
            u32x4 w; w.x = cvt_pk_bf16(o[0], o[1]); w.y = cvt_pk_bf16(o[2], o[3]); w.z = cvt_pk_bf16(o[4], o[5]); w.w = cvt_pk_bf16(o[6], o[7]);
            *(u32x4*)(ACT + (size_t)(m0 + r) * FF + f0) = w;
        }
    }
}

__device__ __forceinline__ void kvpost_pass(const Args& a, const Frame& F) {
    unsigned char* ws = a.ws; const float* KV = (const float*)(ws + WS_KV); const float* knorm = (const float*)a.in[14];
    const int gw = F.vcu * NWAVES + F.wave, NGW = F.G * NWAVES, lane = F.lane;
    bf16_t* ACMP = (bf16_t*)(ws + WS_ACMP);
    for (int m = gw; m < MR; m += NGW) {
        const bool samp = m >= MP; const int b = samp ? (m - MP) >> 3 : m >> 12, t = samp ? (m - MP) & 7 : m & (SEQ - 1);
#pragma unroll 2
        for (int e = 0; e < 24; ++e) {
            const int br = e >> 3, v = (e >> 2) & 1, g = e & 3, bg = b * 4 + g;
            f32x2 raw = *(const f32x2*)(KV + (size_t)m * KVW + e * 128 + 2 * lane);
            if (br > 0 && v == 0) { const float ss = wave_sum(raw[0] * raw[0] + raw[1] * raw[1]); const float rstd = 1.0f / sqrtf(ss * (1.0f / 128.0f) + EPS);
                const f32x2 kn = *(const f32x2*)(knorm + br * 128 + 2 * lane); raw = raw * rstd * kn; }
            const unsigned pk = cvt_pk_bf16(raw[0], raw[1]); const size_t oe = (size_t)(v * 4 + g) * 128 + 2 * lane;
            if (br == 0) {
                if (!samp) { *(f32x2*)(a.out + O_CMPP + (size_t)m * 1024 + oe) = raw;
                    *(unsigned*)(ACMP + ((size_t)v * 2048 + (size_t)bg * 256 + (t >> 4)) * 2048 + (t & 15) * 128 + 2 * lane) = pk; }
                else *(f32x2*)(a.out + O_CMPS + (size_t)(m - MP) * 1024 + oe) = raw;
            } else if (br == 1) {
                if (!samp) { *(f32x2*)(a.out + O_SELP + (size_t)m * 1024 + oe) = raw;
                    *(unsigned*)((bf16_t*)(ws + (v ? WS_VSEL : WS_KSEL)) + ((size_t)bg * SEQ + t) * 128 + 2 * lane) = pk; }
                else { *(f32x2*)(a.out + O_SELS + (size_t)(m - MP) * 1024 + oe) = raw;
                    *(unsigned*)((bf16_t*)(ws + (v ? WS_VSELNS : WS_KSELNS)) + ((size_t)bg * 64 + t) * 128 + 2 * lane) = pk; }
            } else {
                if (!samp) { *(unsigned*)((bf16_t*)(ws + (v ? WS_VWIN : WS_KWIN)) + ((size_t)bg * SEQ + t) * 128 + 2 * lane) = pk;
                    if (t >= SEQ - 512) *(f32x2*)(a.out + O_WINP + ((size_t)b * 512 + (t - (SEQ - 512))) * 1024 + oe) = raw; }
                else { *(unsigned*)((bf16_t*)(ws + (v ? WS_VWINS : WS_KWINS)) + ((size_t)bg * 576 + 512 + t) * 128 + 2 * lane) = pk;
                    *(f32x2*)(a.out + O_WINS + ((size_t)b * 512 + 504 + t) * 1024 + oe) = raw; }
            }
        }
    }
}

__device__ __forceinline__ int crow(int r, int hi) { return (r & 3) + 8 * (r >> 2) + 4 * hi; }
__device__ __forceinline__ float gelu_tanh(float x) { const float u = 0.7978845608028654f * (x + 0.044715f * x * x * x); const float e = __expf(2.0f * u); const float th = 1.0f - 2.0f / (1.0f + e); return 0.5f * x * (1.0f + th); }
__device__ __forceinline__ void cmppost_pass(const Args& a, const Frame& F) {
    unsigned char* ws = a.ws; const float* P = (const float*)(ws + WS_PCMP); const bf16_t* W2T = (const bf16_t*)(ws + WS_W2T); const float* bias = (const float*)(ws + WS_CBIAS);
    const float* kn0 = (const float*)a.in[14];
    const int gw = F.vcu * NWAVES + F.wave, NGW = F.G * NWAVES, lane = F.lane, r32 = lane & 31, hi = lane >> 5;
    constexpr int NIT_P = 2 * 4 * 2 * 8, NIT = NIT_P + 8 * 4 * 2 * 32;
    for (int it = gw; it < NIT; it += NGW) {
        int sgb, g, v, ch, NC, pitch; size_t prow0; bf16_t* dst;
        if (it < NIT_P) { ch = it & 7; v = (it >> 3) & 1; g = (it >> 4) & 3; sgb = it >> 6; NC = NCP; pitch = 256; prow0 = (size_t)v * 2048 + (size_t)(sgb * 4 + g) * 256;
            dst = (bf16_t*)(ws + (v ? WS_VCP : WS_KCP)) + (size_t)(sgb * 4 + g) * 256 * 128; }
        else { const int q = it - NIT_P; ch = q & 31; v = (q >> 5) & 1; g = (q >> 6) & 3; sgb = q >> 8; NC = NCS; pitch = 1024; prow0 = (size_t)CMP_ROW_S0 + (size_t)v * 32768 + (size_t)(sgb * 4 + g) * 1024;
            dst = (bf16_t*)(ws + (v ? WS_VCS : WS_KCS)) + (size_t)(sgb * 4 + g) * 1024 * 128; }
        const int i = ch * 32 + r32; const bool iv = i < NC;
        bf16x8 af[8];
#pragma unroll
        for (int ks = 0; ks < 8; ++ks) { const int h0 = ks * 16 + hi * 8; float hv[8];
            if (iv) { const f32x4 p0 = *(const f32x4*)(P + (prow0 + i) * 256 + h0), p1 = *(const f32x4*)(P + (prow0 + i) * 256 + h0 + 4);
                const f32x4 q0 = *(const f32x4*)(P + (prow0 + i + 1) * 256 + 128 + h0), q1 = *(const f32x4*)(P + (prow0 + i + 1) * 256 + 128 + h0 + 4);
                const f32x4 b0 = *(const f32x4*)(bias + v * 128 + h0), b1 = *(const f32x4*)(bias + v * 128 + h0 + 4);
#pragma unroll
                for (int e = 0; e < 4; ++e) { hv[e] = gelu_tanh(p0[e] + q0[e] + b0[e]); hv[4 + e] = gelu_tanh(p1[e] + q1[e] + b1[e]); } }
            else {
#pragma unroll
                for (int e = 0; e < 8; ++e) hv[e] = 0.f; }
            u32x4 w; w.x = cvt_pk_bf16(hv[0], hv[1]); w.y = cvt_pk_bf16(hv[2], hv[3]); w.z = cvt_pk_bf16(hv[4], hv[5]); w.w = cvt_pk_bf16(hv[6], hv[7]); af[ks] = __builtin_bit_cast(bf16x8, w); }
        f32x16 o[4];
#pragma unroll
        for (int d0 = 0; d0 < 4; ++d0) { o[d0] = (f32x16){};
#pragma unroll
            for (int ks = 0; ks < 8; ++ks) { const bf16x8 bfr = *(const bf16x8*)(W2T + (size_t)v * 128 * 128 + (size_t)(32 * d0 + r32) * 128 + ks * 16 + hi * 8);
                o[d0] = __builtin_amdgcn_mfma_f32_32x32x16_bf16(af[ks], bfr, o[d0], 0, 0, 0); } }
#pragma unroll
        for (int r = 0; r < 16; ++r) {
            float sc = 1.0f;
            if (v == 0) { float ss = o[0][r] * o[0][r] + o[1][r] * o[1][r] + o[2][r] * o[2][r] + o[3][r] * o[3][r];
                ss += __shfl_xor(ss, 1); ss += __shfl_xor(ss, 2); ss += __shfl_xor(ss, 4); ss += __shfl_xor(ss, 8); ss += __shfl_xor(ss, 16);
                sc = 1.0f / sqrtf(ss * (1.0f / 128.0f) + EPS); }
            const int ir = ch * 32 + crow(r, hi);
            if (ir < NC) {
#pragma unroll
                for (int d0 = 0; d0 < 4; ++d0) { const int d = 32 * d0 + r32; const float val = v == 0 ? o[d0][r] * sc * kn0[d] : o[d0][r];
                    dst[(size_t)ir * 128 + d] = (bf16_t)(cvt_pk_bf16(val, 0.f) & 0xffffu); } }
        }
    }
}

namespace nsa {
#define KSWZ(row, colB) ((row) * 256 + ((colB) ^ (((row) & 7) << 4)))
constexpr float LOG2E = 1.4426950408889634f;
constexpr int L_K = 0, L_V = 16384, L_BUF = 32768  , L_PQ = 65536, L_SELM = 131072 + 1024, L_WUN = L_SELM + 64 * 5 * 8, L_WSF = L_WUN + 8 * 5 * 8, L_END = L_WSF + 8 * 64 * 4;
static_assert(L_END <= LDS_BYTES, "attention LDS");
__device__ __forceinline__ int v_st(int k, int c) { const int kk = (k & ~0xC) | ((k & 4) << 1) | ((k & 8) >> 1); return ((kk >> 3) * 4 + (c >> 5)) * 512 + ((kk & 7) * 32 + (c & 31)) * 2; }
__device__ __forceinline__ int v_rd_base(int lane) { return ((lane & 3) << 3) | (((lane >> 2) & 3) << 6) | (((lane >> 4) & 1) << 5) | (((lane >> 5) & 1) << 8); }
constexpr int v_rd_off(int d0, int ks, int half) { return d0 * 512 + ks * 4096 + half * 2048; }
template <int OFF> __device__ __forceinline__ s16x4 tr_read(int vb) { s16x4 r; asm volatile("ds_read_b64_tr_b16 %0, %1 offset:%2" : "=&v"(r) : "v"(vb), "i"(OFF) : "memory"); return r; }
template <int D0> __device__ __forceinline__ void pv_one(f32x16& od, int vb, bf16x8 pa0, bf16x8 pa1, bf16x8 pa2, bf16x8 pa3) {
    const s16x4 l0 = tr_read<v_rd_off(D0, 0, 0)>(vb), h0 = tr_read<v_rd_off(D0, 0, 1)>(vb), l1 = tr_read<v_rd_off(D0, 1, 0)>(vb), h1 = tr_read<v_rd_off(D0, 1, 1)>(vb);
    const s16x4 l2 = tr_read<v_rd_off(D0, 2, 0)>(vb), h2 = tr_read<v_rd_off(D0, 2, 1)>(vb), l3 = tr_read<v_rd_off(D0, 3, 0)>(vb), h3 = tr_read<v_rd_off(D0, 3, 1)>(vb);
    asm volatile("s_waitcnt lgkmcnt(0)" ::: "memory"); SBAR();
#define PK(L, H) (bf16x8){L[0], L[1], L[2], L[3], H[0], H[1], H[2], H[3]}
    od = __builtin_amdgcn_mfma_f32_32x32x16_bf16(pa0, PK(l0, h0), od, 0, 0, 0);
    od = __builtin_amdgcn_mfma_f32_32x32x16_bf16(pa1, PK(l1, h1), od, 0, 0, 0);
    od = __builtin_amdgcn_mfma_f32_32x32x16_bf16(pa2, PK(l2, h2), od, 0, 0, 0);
    od = __builtin_amdgcn_mfma_f32_32x32x16_bf16(pa3, PK(l3, h3), od, 0, 0, 0);
#undef PK
}
__device__ __forceinline__ void pv_d0(f32x16* o, int vb, bf16x8 pa0, bf16x8 pa1, bf16x8 pa2, bf16x8 pa3) {
    pv_one<0>(o[0], vb, pa0, pa1, pa2, pa3); pv_one<1>(o[1], vb, pa0, pa1, pa2, pa3); pv_one<2>(o[2], vb, pa0, pa1, pa2, pa3); pv_one<3>(o[3], vb, pa0, pa1, pa2, pa3);
}
__device__ __forceinline__ void qkt(f32x16& p0, f32x16& p1, const LAS unsigned char* Ks, const bf16x8* qr, int r32, int hi) {
    p0 = (f32x16){}; p1 = (f32x16){};
#pragma unroll
    for (int d0 = 0; d0 < 8; ++d0) { const int cb = (d0 * 16 + hi * 8) * 2;
        const bf16x8 b0 = *(const LAS bf16x8*)(Ks + KSWZ(r32, cb)); const bf16x8 b1 = *(const LAS bf16x8*)(Ks + KSWZ(32 + r32, cb));
        p0 = __builtin_amdgcn_mfma_f32_32x32x16_bf16(b0, qr[d0], p0, 0, 0, 0);
        p1 = __builtin_amdgcn_mfma_f32_32x32x16_bf16(b1, qr[d0], p1, 0, 0, 0); }
}
__device__ __forceinline__ void p_to_frags(const f32x16& p0, const f32x16& p1, bf16x8& pa0, bf16x8& pa1, bf16x8& pa2, bf16x8& pa3) {
#define PK4(P, BASE, OUT) do { unsigned a0 = cvt_pk_bf16(P[BASE + 0], P[BASE + 1]), a1 = cvt_pk_bf16(P[BASE + 2], P[BASE + 3]);   \
    unsigned b0 = cvt_pk_bf16(P[BASE + 4], P[BASE + 5]), b1 = cvt_pk_bf16(P[BASE + 6], P[BASE + 7]);                              \
    auto r0 = __builtin_amdgcn_permlane32_swap(a0, b0, false, false); auto r1 = __builtin_amdgcn_permlane32_swap(a1, b1, false, false); \
    u32x4 w = {r0[0], r1[0], r0[1], r1[1]}; OUT = __builtin_bit_cast(bf16x8, w); } while (0)
    PK4(p0, 0, pa0); PK4(p0, 8, pa1); PK4(p1, 0, pa2); PK4(p1, 8, pa3);
#undef PK4
}
__device__ __forceinline__ float half_swap_max(float v) { auto rr = __builtin_amdgcn_permlane32_swap(__float_as_uint(v), __float_as_uint(v), false, false); return fmaxf(__uint_as_float(rr[0]), __uint_as_float(rr[1])); }
__device__ __forceinline__ float half_swap_sum(float v) { auto rr = __builtin_amdgcn_permlane32_swap(__float_as_uint(v), __float_as_uint(v), false, false); return __uint_as_float(rr[0]) + __uint_as_float(rr[1]); }

__device__ __forceinline__ void stage_bf16(LAS unsigned char* lds, const bf16_t* kp, const bf16_t* vp, bool with_v, int tid_in) {
    int tid = tid_in; asm volatile("" : "+v"(tid));
    const int sr = tid >> 4, sc = (tid & 15) * 8; const unsigned o0 = (unsigned)(sr * 128 + sc) * 2u, o1 = o0 + 32u * 128u * 2u;
    const bf16x8 k0 = *(const bf16x8*)((const char*)kp + o0), k1 = *(const bf16x8*)((const char*)kp + o1);
    bf16x8 v0, v1;
    if (with_v) { v0 = *(const bf16x8*)((const char*)vp + o0); v1 = *(const bf16x8*)((const char*)vp + o1); }
    *(LAS bf16x8*)(lds + L_K + KSWZ(sr, sc * 2)) = k0; *(LAS bf16x8*)(lds + L_K + KSWZ(32 + sr, sc * 2)) = k1;
    if (with_v) { *(LAS bf16x8*)(lds + L_V + v_st(sr, sc)) = v0; *(LAS bf16x8*)(lds + L_V + v_st(32 + sr, sc)) = v1; }
}
__device__ __forceinline__ bf16x8 cvt8(const float* p) { const f32x4 a = *(const f32x4*)p, b = *(const f32x4*)(p + 4);
    u32x4 w; w.x = cvt_pk_bf16(a[0], a[1]); w.y = cvt_pk_bf16(a[2], a[3]); w.z = cvt_pk_bf16(b[0], b[1]); w.w = cvt_pk_bf16(b[2], b[3]); return __builtin_bit_cast(bf16x8, w); }
__device__ __forceinline__ void stage_f32(LAS unsigned char* lds, const float* kp, int tid_in) {
    int tid = tid_in; asm volatile("" : "+v"(tid));
    const int sr = tid >> 4, sc = (tid & 15) * 8; const unsigned o0 = (unsigned)(sr * 1024 + sc), o1 = o0 + 32u * 1024u;
    { const bf16x8 k0 = cvt8(kp + o0), k1 = cvt8(kp + o1);
      *(LAS bf16x8*)(lds + L_K + KSWZ(sr, sc * 2)) = k0; *(LAS bf16x8*)(lds + L_K + KSWZ(32 + sr, sc * 2)) = k1; }
    { const bf16x8 v0 = cvt8(kp + o0 + 512), v1 = cvt8(kp + o1 + 512);
      *(LAS bf16x8*)(lds + L_V + v_st(sr, sc)) = v0; *(LAS bf16x8*)(lds + L_V + v_st(32 + sr, sc)) = v1; }
}

__device__ __forceinline__ void mask_tile(f32x16& p0, f32x16& p1, int tpos, int pos0, int pstride, int dmax, bool rowok, float slope2, int hi) {
    const float NEG = -INFINITY;
#pragma unroll
    for (int r = 0; r < 16; ++r) { const int kk = (r & 3) + 8 * (r >> 2) + 4 * hi;
        const int d0 = tpos - (pos0 + pstride * kk), d1 = d0 - 32 * pstride;
        p0[r] = (rowok && d0 >= 0 && d0 < dmax) ? p0[r] - slope2 * (float)d0 : NEG;
        p1[r] = (rowok && d1 >= 0 && d1 < dmax) ? p1[r] - slope2 * (float)d1 : NEG; }
}
__device__ __forceinline__ void softmax_pv(f32x16& p0, f32x16& p1, float& m_reg, float& l_reg, f32x16* o, int vb, LAS float* wsf, int r32, int hi) {
    float pmax = p0[0];
#pragma unroll
    for (int r = 1; r < 16; ++r) pmax = fmaxf(pmax, p0[r]);
#pragma unroll
    for (int r = 0; r < 16; ++r) pmax = fmaxf(pmax, p1[r]);
    pmax = half_swap_max(pmax);
    const float mn = fmaxf(m_reg, pmax); const float alpha = __builtin_amdgcn_exp2f(m_reg - mn); m_reg = mn;
    float ps = 0.f;
#pragma unroll
    for (int r = 0; r < 16; ++r) { p0[r] = __builtin_amdgcn_exp2f(p0[r] - mn); p1[r] = __builtin_amdgcn_exp2f(p1[r] - mn); ps += p0[r] + p1[r]; }
    ps = half_swap_sum(ps);
    l_reg = l_reg * alpha + ps;
    if (__any(alpha < 1.f)) { if (hi == 0) wsf[r32] = alpha; LDS_WAIT();
#pragma unroll
        for (int r = 0; r < 16; ++r) { const float al = wsf[crow(r, hi)];
#pragma unroll
            for (int d = 0; d < 4; ++d) o[d][r] *= al; }
        LDS_WAIT(); }
    bf16x8 pa0, pa1, pa2, pa3; p_to_frags(p0, p1, pa0, pa1, pa2, pa3);
    pv_d0(o, vb, pa0, pa1, pa2, pa3);
}
template <int MODE>
__device__ __forceinline__ void flush_branch(const f32x16* o, float f, float* OF, bf16_t* OB, int mbase, int g, int nq, int wid, LAS float* wsf, int r32, int hi) {
    LDS_WAIT(); if (hi == 0) wsf[r32] = f; LDS_WAIT();
#pragma unroll
    for (int r = 0; r < 16; ++r) { const int rr = crow(r, hi), hr = rr >> 3, qrow = wid * 8 + (rr & 7); const float fr = wsf[rr];
        if (qrow < nq) { const size_t base = (size_t)(mbase + qrow) * D + (g * 4 + hr) * 128 + r32;
#pragma unroll
            for (int d0 = 0; d0 < 4; ++d0) { float v = fr * o[d0][r];
                if (MODE > 0) v += __hip_atomic_load(OF + base + 32 * d0, __ATOMIC_RELAXED, __HIP_MEMORY_SCOPE_AGENT);
                if (MODE < 2) OF[base + 32 * d0] = v; else OB[base + 32 * d0] = (bf16_t)(cvt_pk_bf16(v, 0.f) & 0xffffu); } } }
    LDS_WAIT();
}

__device__ __forceinline__ void glds16(const void* gsrc, unsigned lds_dst) { unsigned keep;
    asm volatile("s_mov_b32 %0, m0\n\ts_mov_b32 m0, %2\n\ts_nop 0\n\tglobal_load_lds_dwordx4 %1, off\n\ts_mov_b32 m0, %0" : "=&s"(keep) : "v"(gsrc), "s"(lds_dst) : "memory"); }
struct DmaMap { unsigned ko[2], vo[2]; };
__device__ __forceinline__ DmaMap dma_map(int wid, int lane) {
    DmaMap d;
#pragma unroll
    for (int i = 0; i < 2; ++i) { const int o = (wid * 2 + i) * 1024 + lane * 16;
        const int row = o >> 8, c = ((o >> 4) & 15) ^ (row & 7); d.ko[i] = (unsigned)(row * 128 + c * 8);
        const int sub = o >> 9, within = (o & 511) >> 1, kk = (sub >> 2) * 8 + (within >> 5), k = (kk & ~0xC) | ((kk & 4) << 1) | ((kk & 8) >> 1), cc = (sub & 3) * 32 + (within & 31);
        d.vo[i] = (unsigned)(k * 128 + cc); }
    return d;
}
__device__ __forceinline__ void dma_tile(unsigned ldsbuf  , const bf16_t* kp, const bf16_t* vp, bool with_v, const DmaMap& dm, int wid) {
    const unsigned d0 = __builtin_amdgcn_readfirstlane(ldsbuf + (unsigned)wid * 2048u);
    glds16(kp + dm.ko[0], d0); glds16(kp + dm.ko[1], d0 + 1024u);
    if (with_v) { glds16(vp + dm.vo[0], d0 + 16384u); glds16(vp + dm.vo[1], d0 + 16384u + 1024u); }
}

__device__ __forceinline__ void attn_unit(const Args& a, const Frame& F, int lj, bool samp, int b, int g, int qt) {
    unsigned char* ws = a.ws; LAS unsigned char* lds = F.lds;
    const int tid = F.tid, wid = F.wave, lane = F.lane, r32 = lane & 31, hi = lane >> 5;
    const int head = r32 >> 3, qi = r32 & 7, qq = wid * 8 + qi, nq = samp ? 8 : 64, bg = b * 4 + g;
    const bool rowok = qq < nq; const bool wactive = samp ? (wid == 0) : true;
    const int t0 = samp ? PAST : qt * 64, tpos = t0 + qq;
    const int mbase = samp ? MP + b * 8 : b * SEQ + qt * 64;
    const int mrow = mbase + (rowok ? qq : 0);
    const int hg = g * 4 + head;
    const float slope2 = exp2f(-0.5f * (float)(hg + 1)) * LOG2E;
    LAS float* wsf = (LAS float*)(lds + L_WSF) + wid * 64;
    LAS float* Pq = (LAS float*)(lds + L_PQ); const int pq_pitch = samp ? 1024 : 256;
    LAS u64* selm = (LAS u64*)(lds + L_SELM); LAS u64* wun = (LAS u64*)(lds + L_WUN);
    const unsigned lds0 = (unsigned)(uintptr_t)lds;
    const int vb0 = (int)lds0 + L_V + v_rd_base(lane);
    const DmaMap dm = dma_map(wid, lane);
    const float* QG = (const float*)(ws + WS_QG);
    bf16x8 qr[8];
    { const float* qp = QG + (size_t)mrow * QGP + hg * 128 + hi * 8; const float* qn = (const float*)a.in[19] + lj * 128 + hi * 8;
      f32x4 qa[8][2]; float ss = 0.f;
#pragma unroll
      for (int d0 = 0; d0 < 8; ++d0) { qa[d0][0] = *(const f32x4*)(qp + d0 * 16); qa[d0][1] = *(const f32x4*)(qp + d0 * 16 + 4);
#pragma unroll
          for (int e = 0; e < 4; ++e) ss += qa[d0][0][e] * qa[d0][0][e] + qa[d0][1][e] * qa[d0][1][e]; }
      ss = half_swap_sum(ss);
      const float sc = (1.0f / sqrtf(ss * (1.0f / 128.0f) + EPS)) * 0.08838834764831845f * LOG2E;
#pragma unroll
      for (int d0 = 0; d0 < 8; ++d0) { const f32x4 n0 = *(const f32x4*)(qn + d0 * 16), n1 = *(const f32x4*)(qn + d0 * 16 + 4); const f32x4 x0 = qa[d0][0] * n0 * sc, x1 = qa[d0][1] * n1 * sc;
          u32x4 w; w.x = cvt_pk_bf16(x0[0], x0[1]); w.y = cvt_pk_bf16(x0[2], x0[3]); w.z = cvt_pk_bf16(x1[0], x1[1]); w.w = cvt_pk_bf16(x1[2], x1[3]); qr[d0] = __builtin_bit_cast(bf16x8, w); } }
    float gate[3];
#pragma unroll
    for (int br = 0; br < 3; ++br) { const float x = QG[(size_t)mrow * QGP + 2048 + hg * 3 + br]; gate[br] = 1.0f / (1.0f + __expf(-x)); }

    f32x16 o[4]; float* OF = (float*)(ws + WS_OF32); bf16_t* OBp = (bf16_t*)(ws + WS_OB);
    const int ncv = samp ? NCS : (4 * qt + 3 < NCP ? 4 * qt + 3 : NCP); const int ntc = (ncv + 63) >> 6;
    const bf16_t* KC = (const bf16_t*)(ws + (samp ? WS_KCS : WS_KCP)) + (size_t)bg * (samp ? 1024 : 256) * 128;
    const bf16_t* VC = (const bf16_t*)(ws + (samp ? WS_VCS : WS_VCP)) + (size_t)bg * (samp ? 1024 : 256) * 128;
    float m_c = -1e30f, l_c = 0.f;
    __syncthreads();
    dma_tile(lds0, KC, nullptr, false, dm, wid);
    for (int tl = 0; tl < ntc; ++tl) {
        VM_WAIT(); __syncthreads();
        if (tl + 1 < ntc) dma_tile(lds0 + ((tl + 1) & 1) * L_BUF, KC + (size_t)(tl + 1) * 64 * 128, nullptr, false, dm, wid);
        if (wactive) { f32x16 p0, p1; qkt(p0, p1, lds + (tl & 1) * L_BUF + L_K, qr, r32, hi);
            mask_tile(p0, p1, tpos, 16 * 64 * tl + 31, 16, 1 << 30, rowok, slope2, hi);
            float pmax = p0[0];
#pragma unroll
            for (int r = 1; r < 16; ++r) pmax = fmaxf(pmax, p0[r]);
#pragma unroll
            for (int r = 0; r < 16; ++r) pmax = fmaxf(pmax, p1[r]);
            pmax = half_swap_max(pmax);
            const float mn = fmaxf(m_c, pmax); float ps = 0.f;
#pragma unroll
            for (int r = 0; r < 16; ++r) ps += __builtin_amdgcn_exp2f(p0[r] - mn) + __builtin_amdgcn_exp2f(p1[r] - mn);
            ps = half_swap_sum(ps);
            l_c = l_c * __builtin_amdgcn_exp2f(m_c - mn) + ps; m_c = mn; }
    }
#pragma unroll
    for (int d = 0; d < 4; ++d) o[d] = (f32x16){};
    const float inv_c = l_c > 0.f ? 1.0f / l_c : 0.f;
    __syncthreads();
    dma_tile(lds0, KC, VC, true, dm, wid);
    for (int tl = 0; tl < ntc; ++tl) {
        VM_WAIT(); __syncthreads();
        if (tl + 1 < ntc) dma_tile(lds0 + ((tl + 1) & 1) * L_BUF, KC + (size_t)(tl + 1) * 64 * 128, VC + (size_t)(tl + 1) * 64 * 128, true, dm, wid);
        if (wactive) { f32x16 p0, p1; qkt(p0, p1, lds + (tl & 1) * L_BUF + L_K, qr, r32, hi);
            mask_tile(p0, p1, tpos, 16 * 64 * tl + 31, 16, 1 << 30, rowok, slope2, hi);
#pragma unroll
            for (int r = 0; r < 16; ++r) { p0[r] = __builtin_amdgcn_exp2f(p0[r] - m_c) * inv_c; p1[r] = __builtin_amdgcn_exp2f(p1[r] - m_c) * inv_c; }
#pragma unroll
            for (int r = 0; r < 16; ++r) { float s0 = p0[r], s1 = p1[r]; s0 += __shfl_xor(s0, 8); s0 += __shfl_xor(s0, 16); s1 += __shfl_xor(s1, 8); s1 += __shfl_xor(s1, 16);
                if (head == 0 && rowok) { const int kk = crow(r, hi); Pq[qq * pq_pitch + tl * 64 + kk] = s0; Pq[qq * pq_pitch + tl * 64 + 32 + kk] = s1; } }
            bf16x8 pa0, pa1, pa2, pa3; p_to_frags(p0, p1, pa0, pa1, pa2, pa3);
            pv_d0(o, vb0 + (tl & 1) * L_BUF, pa0, pa1, pa2, pa3); }
    }
    if (wactive) flush_branch<0>(o, gate[0], OF, OBp, mbase, g, nq, wid, wsf, r32, hi);
    __syncthreads();
    if (!samp) dma_tile(lds0, (const bf16_t*)(ws + WS_KSEL) + (size_t)bg * SEQ * 128, (const bf16_t*)(ws + WS_VSEL) + (size_t)bg * SEQ * 128, true, dm, wid);
    const int nw = samp ? 5 : 1, nb = samp ? 257 : 64, nproc = ntc * 64;
    u64 myun[5] = {0ull, 0ull, 0ull, 0ull, 0ull};
    if (wactive) {
        for (int q2 = 0; q2 < 8; ++q2) {
            const int qq2 = wid * 8 + q2, t2 = t0 + qq2, cur = t2 >> 6;
            unsigned key[5]; bool vld[5];
#pragma unroll
            for (int w = 0; w < 5; ++w) { key[w] = 0u; vld[w] = false;
                if (w < nw) { const int jb = lane + 64 * w; float imp = 0.f;
#pragma unroll
                    for (int e = -1; e < 4; ++e) { const int c = 4 * jb + e; if (c >= 0 && c < nproc && jb < nb) imp += Pq[qq2 * pq_pitch + c]; }
                    const bool forced = (jb == 0) || (jb == cur) || (jb == cur - 1); vld[w] = (jb < nb) && (64 * jb <= t2);
                    const float val = vld[w] ? (forced ? imp + 1e4f : imp) : -1e30f; const unsigned bits = __float_as_uint(val);
                    key[w] = (jb < nb) ? ((bits & 0x80000000u) ? ~bits : (bits | 0x80000000u)) : 0u; } }
            unsigned T = 0u;
            for (int bit = 31; bit >= 0; --bit) { const unsigned cand = T | (1u << bit); int cnt = 0;
#pragma unroll
                for (int w = 0; w < 5; ++w) if (w < nw) cnt += __popcll(__ballot(key[w] >= cand));
                if (cnt >= 16) T = cand; }
            int ngt = 0;
#pragma unroll
            for (int w = 0; w < 5; ++w) if (w < nw) ngt += __popcll(__ballot(key[w] > T));
            int need = 16 - ngt, prev = 0;
#pragma unroll
            for (int w = 0; w < 5; ++w) if (w < nw) {
                const u64 eq = __ballot(key[w] == T); const int rank = prev + __popcll(eq & ((1ull << lane) - 1ull)); prev += __popcll(eq);
                const bool sel = (key[w] > T) || (key[w] == T && rank < need);
                const u64 mk = __ballot(sel && vld[w]);
                if (lane == 0) selm[qq2 * 5 + w] = mk;
                if (qq2 < nq) myun[w] |= mk; }
        }
    }
    if (lane == 0) {
#pragma unroll
        for (int w = 0; w < 5; ++w) if (w < nw) wun[wid * 5 + w] = myun[w]; }
    __syncthreads();
    float m_s = -1e30f, l_s = 0.f;
#pragma unroll
    for (int d = 0; d < 4; ++d) o[d] = (f32x16){};
    if (!samp) {
        const bf16_t* KS = (const bf16_t*)(ws + WS_KSEL) + (size_t)bg * SEQ * 128; const bf16_t* VS = (const bf16_t*)(ws + WS_VSEL) + (size_t)bg * SEQ * 128;
        u64 U = 0ull;
#pragma unroll
        for (int x = 0; x < 8; ++x) U |= wun[x * 5];
        { const unsigned ulo = __builtin_amdgcn_readfirstlane((unsigned)U), uhi = __builtin_amdgcn_readfirstlane((unsigned)(U >> 32)); U = ((u64)uhi << 32) | ulo; }
        const u64 mysel = rowok ? selm[qq * 5] : 0ull;
        U |= 1ull;
        int cur = 0, it = 0; U &= U - 1ull;
        while (cur >= 0) {
            const int nxt = U ? __builtin_ctzll(U) : -1; U &= U - 1ull;
            VM_WAIT(); __syncthreads();
            if (nxt >= 0) dma_tile(lds0 + ((it + 1) & 1) * L_BUF, KS + (size_t)nxt * 64 * 128, VS + (size_t)nxt * 64 * 128, true, dm, wid);
            { f32x16 p0, p1; qkt(p0, p1, lds + (it & 1) * L_BUF + L_K, qr, r32, hi);
              mask_tile(p0, p1, tpos, 64 * cur, 1, 1 << 30, rowok && ((mysel >> cur) & 1ull), slope2, hi);
              softmax_pv(p0, p1, m_s, l_s, o, vb0 + (it & 1) * L_BUF, wsf, r32, hi); }
            cur = nxt; ++it;
        }
    } else {
        const float* cache = (const float*)a.in[3]; const int* pt = (const int*)a.in[4] + b * 128;
        for (int w = 0; w < nw; ++w) {
            u64 U = 0ull;
#pragma unroll
            for (int x = 0; x < 8; ++x) U |= wun[x * 5 + w];
            { const unsigned ulo = __builtin_amdgcn_readfirstlane((unsigned)U), uhi = __builtin_amdgcn_readfirstlane((unsigned)(U >> 32)); U = ((u64)uhi << 32) | ulo; }
            const u64 mysel = rowok ? selm[qq * 5 + w] : 0ull;
            while (U) {
                const int bit = __builtin_ctzll(U); U &= U - 1ull; const int jb = 64 * w + bit;
                __syncthreads();
                if (jb < 256) stage_f32(lds, cache + ((size_t)pt[jb >> 1] * 128 + (jb & 1) * 64) * 1024 + g * 128, tid);
                else stage_bf16(lds, (const bf16_t*)(ws + WS_KSELNS) + (size_t)bg * 64 * 128, (const bf16_t*)(ws + WS_VSELNS) + (size_t)bg * 64 * 128, true, tid);
                __syncthreads();
                if (wactive) { f32x16 p0, p1; qkt(p0, p1, lds + L_K, qr, r32, hi);
                    mask_tile(p0, p1, tpos, 64 * jb, 1, 1 << 30, rowok && ((mysel >> bit) & 1ull), slope2, hi);
                    softmax_pv(p0, p1, m_s, l_s, o, vb0, wsf, r32, hi); }
            }
        }
    }
    if (wactive) flush_branch<1>(o, l_s > 0.f ? gate[1] / l_s : 0.f, OF, OBp, mbase, g, nq, wid, wsf, r32, hi);
    float m_w = -1e30f, l_w = 0.f;
#pragma unroll
    for (int d = 0; d < 4; ++d) o[d] = (f32x16){};
    {
        const bf16_t* KW = samp ? (const bf16_t*)(ws + WS_KWINS) + (size_t)bg * 576 * 128 : (const bf16_t*)(ws + WS_KWIN) + (size_t)bg * SEQ * 128;
        const bf16_t* VW = samp ? (const bf16_t*)(ws + WS_VWINS) + (size_t)bg * 576 * 128 : (const bf16_t*)(ws + WS_VWIN) + (size_t)bg * SEQ * 128;
        const int jlo = samp ? 0 : (qt >= 8 ? qt - 8 : 0), jhi = samp ? 8 : qt, posb = samp ? PAST - 512 : 0;
        __syncthreads();
        dma_tile(lds0, KW + (size_t)jlo * 64 * 128, VW + (size_t)jlo * 64 * 128, true, dm, wid);
        for (int jt = jlo; jt <= jhi; ++jt) { const int it = jt - jlo;
            VM_WAIT(); __syncthreads();
            if (jt < jhi) dma_tile(lds0 + ((it + 1) & 1) * L_BUF, KW + (size_t)(jt + 1) * 64 * 128, VW + (size_t)(jt + 1) * 64 * 128, true, dm, wid);
            if (wactive) { f32x16 p0, p1; qkt(p0, p1, lds + (it & 1) * L_BUF + L_K, qr, r32, hi);
                mask_tile(p0, p1, tpos, posb + 64 * jt, 1, 512, rowok, slope2, hi);
                softmax_pv(p0, p1, m_w, l_w, o, vb0 + (it & 1) * L_BUF, wsf, r32, hi); }
        }
    }
    if (wactive) flush_branch<2>(o, l_w > 0.f ? gate[2] / l_w : 0.f, OF, OBp, mbase, g, nq, wid, wsf, r32, hi);
    __syncthreads();
}

__device__ __forceinline__ void attn_phase(const Args& a, const Frame& F, int lj) {
    const int G = F.G;
    if (G == 256) { if ((F.vcu & 63) < 8) { const int us = (F.vcu >> 6) * 8 + (F.vcu & 63); attn_unit(a, F, lj, true, us >> 2, us & 3, 0); } }
    else for (int us = F.vcu; us < 32; us += G) attn_unit(a, F, lj, true, us >> 2, us & 3, 0);
    for (int rnd = 0; rnd * G < 512; ++rnd) {
        const int id = (rnd & 1) ? (rnd + 1) * G - 1 - F.vcu : rnd * G + F.vcu;
        if (id < 512) attn_unit(a, F, lj, false, (id >> 6) >> 2, (id >> 6) & 3, id & 63);
    }
}
}

#ifndef PHMASK
#define PHMASK 0xFFFFFFFFu
#endif
#define PH(n) ((PHMASK >> (n)) & 1u)
__global__ void __launch_bounds__(NTHR, 2) mega_fwd(Args a) {
    extern __shared__ __attribute__((aligned(16))) unsigned char lds_raw[];
    Frame F; F.lds = (LAS unsigned char*)lds_raw; F.tid = threadIdx.x; F.lane = F.tid & 63; F.wave = __builtin_amdgcn_readfirstlane(F.tid >> 6);
    F.G = gridDim.x; { const int bx = blockIdx.x; F.vcu = (F.G % 8 == 0) ? (bx % 8) * (F.G / 8) + bx / 8 : bx; }
    unsigned char* ws = a.ws;
    volatile LAS unsigned* MISC = (volatile LAS unsigned*)(F.lds + MISC_OFF);
    for (int u = F.tid; u < (LDS_BYTES - LDSCTL_OFF) / 4; u += NTHR) ((LAS unsigned*)(F.lds + LDSCTL_OFF))[u] = 0u;
    __syncthreads();
    XcdBarrier bar = xcd_barrier_post((unsigned*)(ws + WS_CTL) + CW_BAR, MISC + 8);
    const int cblk = (int)blockIdx.x;
#define RELAUNDER() do { int t_ = threadIdx.x; asm volatile("" : "+v"(t_)); F.tid = t_; F.lane = t_ & 63; F.wave = __builtin_amdgcn_readfirstlane(t_ >> 6); asm volatile("" : "+s"(ws)); } while (0)

    RELAUNDER(); if (PH(0)) p0_prologue(a, F);
    xcd_barrier(bar);

    for (int l = 0; l < 4; ++l) {
        float* X = (float*)(ws + WS_X); bf16_t* XB = (bf16_t*)(ws + WS_XB);
        float* rowp_ffn = (float*)(ws + WS_ROWP + (size_t)(2 * l + 1) * ROWP_STRIDE);
        if (l < 2) {
            RELAUNDER(); if (PH(1)) pool_pass(a, F, l);
            xcd_barrier(bar);
            RELAUNDER(); if (PH(2)) { SchedMix S; S.o.init(NTM - 1, 8, F.G, cblk);
              EpiResid E{X, X, XB, rowp_ffn, (const float*)a.in[11] + l * D, MR};
              pg8::gemm_phase<EpiResid, SchedMix, true>(F.lds, (const char*)(ws + WS_POOLED), (const char*)(ws + WS_WPOOL) + (size_t)l * 4 * 512 * 512 * 2, D, 512, 512, S, E);
              for (int nb = F.vcu; nb < 32; nb += F.G) { const int g = nb >> 3;
                  mini_resid(F.lds, F.tid, (const bf16_t*)(ws + WS_POOLED) + (size_t)MP * D + g * 512, D, (const bf16_t*)(ws + WS_WPOOL) + ((size_t)(l * 4 + g) * 512 + (nb & 7) * 64) * 512, 512, 512, nb,
                             X, X, XB, rowp_ffn, (const float*)a.in[11] + l * D, MP); } }
            xcd_barrier(bar);
        } else {
            const int lj = l - 2;
            RELAUNDER(); if (PH(3)) { SchedPlain S; S.o.init(NTM, lj == 0 ? 21 : 9, F.G, cblk); S.astep = (size_t)256 * D * 2; S.bstep = (size_t)256 * D * 2;
              const float* rowp_mix = (const float*)(ws + WS_ROWP + (size_t)(2 * l) * ROWP_STRIDE);
              EpiF32 E{rowp_mix, lj == 0 ? (float*)(ws + WS_KV) : (float*)(ws + WS_QG), lj == 0 ? KVW : QGP, lj == 0 ? 12 : 1000, (float*)(ws + WS_QG), QGP};
              pg8::gemm_phase<EpiF32, SchedPlain, true>(F.lds, (const char*)XB, (const char*)(ws + (lj == 0 ? WS_WKVQG : WS_WQG1)), D, D, D, S, E); }
            xcd_barrier(bar);
            if (lj == 0) {
                RELAUNDER(); if (PH(4)) kvpost_pass(a, F);
                xcd_barrier(bar);
                RELAUNDER(); if (PH(5)) { SchedCmp S; S.o.init(CMP_ROWS / 256, 1, F.G, cblk);
                  EpiF32 E{nullptr, (float*)(ws + WS_PCMP), 256, 1000, nullptr, 0};
                  pg8::gemm_phase<EpiF32, SchedCmp, true>(F.lds, (const char*)(ws + WS_ACMP), (const char*)(ws + WS_W1CAT), 2048, 2048, 2048, S, E); }
                xcd_barrier(bar);
                RELAUNDER(); if (PH(6)) cmppost_pass(a, F);
                xcd_barrier(bar);
            }
            RELAUNDER(); if (PH(7)) nsa::attn_phase(a, F, lj);
            xcd_barrier(bar);
            RELAUNDER(); if (PH(8)) { SchedPlain S; S.o.init(NTM - 1, 8, F.G, cblk); S.astep = (size_t)256 * D * 2; S.bstep = (size_t)256 * D * 2;
              EpiResid E{X, X, XB, rowp_ffn, nullptr, MR};
              pg8::gemm_phase<EpiResid, SchedPlain, true>(F.lds, (const char*)(ws + WS_OB), (const char*)(ws + WS_WO) + (size_t)lj * D * D * 2, D, D, D, S, E);
              for (int nb = F.vcu; nb < 32; nb += F.G)
                  mini_resid(F.lds, F.tid, (const bf16_t*)(ws + WS_OB) + (size_t)MP * D, D, (const bf16_t*)(ws + WS_WO) + (size_t)lj * D * D + (size_t)nb * 64 * D, D, D, nb, X, X, XB, rowp_ffn, nullptr, MP); }
            xcd_barrier(bar);
        }
        RELAUNDER(); if (PH(9)) { SchedPlain S; S.o.init(NTM, 44, F.G, cblk); S.astep = (size_t)256 * D * 2; S.bstep = (size_t)256 * D * 2;
          EpiHH E{rowp_ffn, (bf16_t*)(ws + WS_HH), a.out + O_CONVP + (size_t)l * NBP * 2 * FF2, a.out + O_CONVS + (size_t)l * NBS * 2 * FF2};
          pg8::gemm_phase<EpiHH, SchedPlain, true>(F.lds, (const char*)XB, (const char*)(ws + WS_WIN) + (size_t)l * FF2 * D * 2, D, D, D, S, E); }
        xcd_barrier(bar);
#ifdef DUP_G1
        RELAUNDER(); if (PH(9)) { SchedPlain S; S.o.init(NTM, 44, F.G, cblk); S.astep = (size_t)256 * D * 2; S.bstep = (size_t)256 * D * 2;
          EpiHH E{rowp_ffn, (bf16_t*)(ws + WS_HH), a.out + O_CONVP + (size_t)l * NBP * 2 * FF2, a.out + O_CONVS + (size_t)l * NBS * 2 * FF2};
          pg8::gemm_phase<EpiHH, SchedPlain, true>(F.lds, (const char*)XB, (const char*)(ws + WS_WIN) + (size_t)l * FF2 * D * 2, D, D, D, S, E); }
        xcd_barrier(bar);
#endif
        RELAUNDER(); if (PH(10)) convgate_pass(a, F, l);
        xcd_barrier(bar);
#ifdef DUP_G2
        RELAUNDER(); if (PH(11)) { SchedPlain S; S.o.init(NTM - 1, 8, F.G, cblk); S.astep = (size_t)256 * FF * 2; S.bstep = (size_t)256 * FF * 2;
          float* rowp_next = l < 3 ? (float*)(ws + WS_ROWP + (size_t)(2 * l + 2) * ROWP_STRIDE) : nullptr;
          EpiResid E{X, (float*)(ws + WS_OF32), nullptr, nullptr, nullptr, MR};
          pg8::gemm_phase<EpiResid, SchedPlain, true>(F.lds, (const char*)(ws + WS_ACT), (const char*)(ws + WS_WOUT) + (size_t)l * D * FF * 2, FF, FF, FF, S, E);
          for (int nb = F.vcu; nb < 32; nb += F.G)
              mini_resid(F.lds, F.tid, (const bf16_t*)(ws + WS_ACT) + (size_t)MP * FF, FF, (const bf16_t*)(ws + WS_WOUT) + (size_t)l * D * FF + (size_t)nb * 64 * FF, FF, FF, nb,
                         X, (float*)(ws + WS_OF32), nullptr, nullptr, nullptr, MP); }
        xcd_barrier(bar);
#endif
        RELAUNDER(); if (PH(11)) { SchedPlain S; S.o.init(NTM - 1, 8, F.G, cblk); S.astep = (size_t)256 * FF * 2; S.bstep = (size_t)256 * FF * 2;
          float* rowp_next = l < 3 ? (float*)(ws + WS_ROWP + (size_t)(2 * l + 2) * ROWP_STRIDE) : nullptr;
          EpiResid E{X, l < 3 ? X : a.out, l < 3 ? XB : nullptr, rowp_next, nullptr, MR};
          pg8::gemm_phase<EpiResid, SchedPlain, true>(F.lds, (const char*)(ws + WS_ACT), (const char*)(ws + WS_WOUT) + (size_t)l * D * FF * 2, FF, FF, FF, S, E);
          for (int nb = F.vcu; nb < 32; nb += F.G)
              mini_resid(F.lds, F.tid, (const bf16_t*)(ws + WS_ACT) + (size_t)MP * FF, FF, (const bf16_t*)(ws + WS_WOUT) + (size_t)l * D * FF + (size_t)nb * 64 * FF, FF, FF, nb,
                         X, l < 3 ? X : a.out, l < 3 ? XB : nullptr, rowp_next, nullptr, MP); }
        if (l < 3) xcd_barrier(bar);
    }
}

extern "C" void kernel_launch(void* const* d_in, const int* in_sizes, int n_in, void* d_out, int out_size, void* d_ws, size_t ws_size, hipStream_t stream) {
    static int grid = 0;
    if (grid == 0) {
        if (n_in != 25 || out_size != (int)O_END || ws_size < WS_END) { fprintf(stderr, "kernel_launch: unexpected shapes: n_in %d out %d ws %zu (need %zu)\n", n_in, out_size, ws_size, (size_t)WS_END); grid = -1; return; }
        int dev = 0, cus = 0, per_cu = 0;
        if (hipGetDevice(&dev) != hipSuccess || hipDeviceGetAttribute(&cus, hipDeviceAttributeMultiprocessorCount, dev) != hipSuccess) { grid = -1; return; }
        if (hipFuncSetAttribute((const void*)mega_fwd, hipFuncAttributeMaxDynamicSharedMemorySize, LDS_BYTES) != hipSuccess) { fprintf(stderr, "kernel_launch: hipFuncSetAttribute failed\n"); grid = -1; return; }
        if (hipOccupancyMaxActiveBlocksPerMultiprocessor(&per_cu, (const void*)mega_fwd, NTHR, LDS_BYTES) != hipSuccess || per_cu < 1) fprintf(stderr, "kernel_launch: occupancy query says %d\n", per_cu);
        (void)hipGetLastError();
        grid = cus;
    }
    if (grid < 0) return;
    (void)hipMemsetAsync((char*)d_ws + WS_CTL, 0, CTL_ZERO_BYTES, stream);
    Args a{};
    for (int i = 0; i < 25; ++i) a.in[i] = d_in[i];
    a.out = (float*)d_out; a.ws = (unsigned char*)d_ws;
    hipLaunchKernelGGL(mega_fwd, dim3(grid), dim3(NTHR), LDS_BYTES, stream, a);
    const hipError_t le = hipPeekAtLastError();
    if (le != hipSuccess) fprintf(stderr, "kernel_launch: launch failed: %s\n", hipGetErrorName(le));
}
```

```cpp
#include <hip/hip_runtime.h>
#include <cstdio>
#include <cstdint>

#define GAS __attribute__((address_space(1)))
#define LAS __attribute__((address_space(3)))
typedef unsigned short bf16_t;
typedef short bf16x8 __attribute__((ext_vector_type(8)));
typedef short s16x4 __attribute__((ext_vector_type(4)));
typedef float f32x2 __attribute__((ext_vector_type(2)));
typedef float f32x4 __attribute__((ext_vector_type(4)));
typedef float f32x8 __attribute__((ext_vector_type(8)));
typedef float f32x16 __attribute__((ext_vector_type(16)));
typedef unsigned u32x2 __attribute__((ext_vector_type(2)));
typedef unsigned u32x4 __attribute__((ext_vector_type(4)));
typedef unsigned long long u64;

constexpr int D = 2048, SEQ = 4096, NBP = 2, NBS = 8, TS = 8, PAST = 16384;
constexpr int MP = NBP * SEQ, MS = NBS * TS, MR = MP + MS, MPAD = 8448, NTM = MPAD / 256;
constexpr int FF = 5632, FF2 = 11264, NG = 4, HD = 128;
constexpr int KVW = 3072, QGW = 2096, QGP = 2304;
constexpr int NCP = 255, NCS = 1023;
constexpr float EPS = 1e-6f;
constexpr int NWAVES = 8, NTHR = 512;

constexpr size_t O_Y = 0, O_CMPP = 16908288, O_CMPS = 25296896, O_SELP = 25362432, O_SELS = 33751040, O_WINP = 33816576, O_WINS = 34865152,
                 O_POOLP = 39059456, O_POOLS = 39182336, O_CONVP = 39673856, O_CONVS = 39854080, O_END = 40574976;

constexpr size_t MiB = 1u << 20;
constexpr size_t WS_CTL = 0, CTL_ZERO_BYTES = 1 * MiB;
constexpr size_t WS_ROWP = 2 * MiB;
constexpr size_t ROWP_STRIDE = 2 * MiB;
constexpr size_t WS_WPOOL = 18 * MiB;
constexpr size_t WS_WIN = 22 * MiB;
constexpr size_t WS_WOUT = 198 * MiB;
constexpr size_t WS_WKVQG = 286 * MiB;
constexpr size_t WS_WQG1 = 307 * MiB;
constexpr size_t WS_WO = 316 * MiB;
constexpr size_t WS_W1CAT = 332 * MiB;
constexpr size_t WS_W2T = 334 * MiB;
constexpr size_t WS_CBIAS = 334 * MiB + 256 * 1024;
constexpr size_t WS_X = 335 * MiB;
constexpr size_t WS_XB = 401 * MiB;
constexpr size_t WS_POOLED = 434 * MiB;
constexpr size_t WS_HH = 467 * MiB;
constexpr size_t WS_ACT = 649 * MiB;
constexpr size_t WS_KV = 740 * MiB;
constexpr size_t WS_QG = 839 * MiB;
constexpr size_t WS_OB = 914 * MiB;
constexpr size_t WS_KSEL = 947 * MiB, WS_VSEL = 955 * MiB, WS_KWIN = 963 * MiB, WS_VWIN = 971 * MiB;
constexpr size_t WS_KCP = 979 * MiB, WS_VCP = 979 * MiB + 512 * 1024;
constexpr size_t WS_KCS = 980 * MiB, WS_VCS = 988 * MiB;
constexpr size_t WS_KWINS = 996 * MiB, WS_VWINS = 1001 * MiB;
constexpr size_t WS_KSELNS = 1006 * MiB, WS_VSELNS = 1006 * MiB + 512 * 1024;
constexpr size_t WS_ACMP = 1007 * MiB;
constexpr size_t WS_PCMP = 1279 * MiB;
constexpr size_t WS_OF32 = 1347 * MiB;
constexpr size_t WS_EDGE = 1413 * MiB;
constexpr size_t WS_END = 1419 * MiB;
constexpr int CMP_ROWS = 69632, CMP_ROW_S0 = 4096;

constexpr int CW_TMO = 0, CW_BAR = 4096;

constexpr int RING_BYTES = 131072, LDSCTL_OFF = RING_BYTES, MISC_OFF = LDSCTL_OFF + 320, LDS_BYTES = 147456;

#define LDS_WAIT() asm volatile("s_waitcnt lgkmcnt(0)" ::: "memory")
#define VM_WAIT() asm volatile("s_waitcnt vmcnt(0)" ::: "memory")
#define SBAR() __builtin_amdgcn_sched_barrier(0)
__device__ __forceinline__ unsigned cvt_pk_bf16(float lo, float hi) { unsigned r; asm volatile("v_cvt_pk_bf16_f32 %0, %1, %2" : "=v"(r) : "v"(lo), "v"(hi)); return r; }
__device__ __forceinline__ float bf2f(bf16_t v) { return __uint_as_float((unsigned)v << 16); }
__device__ __forceinline__ float wave_sum(float v);

__device__ __forceinline__ int lane_id() { int r; asm volatile("v_mbcnt_lo_u32_b32 %0, -1, 0\n\tv_mbcnt_hi_u32_b32 %0, -1, %0" : "=v"(r)); return r; }
template <int K> __device__ __forceinline__ float xadd(float s) {
    if constexpr (K == 32) { auto rr = __builtin_amdgcn_permlane32_swap(__float_as_uint(s), __float_as_uint(s), false, false); return __uint_as_float(rr[0]) + __uint_as_float(rr[1]); }
    else return s + __int_as_float(__builtin_amdgcn_ds_swizzle(__float_as_int(s), (K << 10) | 0x1f));
}
__device__ __forceinline__ float wave_sum(float v) { v = xadd<1>(v); v = xadd<2>(v); v = xadd<4>(v); v = xadd<8>(v); v = xadd<16>(v); return xadd<32>(v); }
#define XB_TMO      128
#define XB_XCNT(j)  (256  + 64 * (j))
#define XB_XSUB(j)  (1280 + 64 * (j))
#define XB_XGEN(j)  (2304 + 64 * (j))
#define XB_TOP      3328
#define XB_TOPGEN   3392
#define XCD_BAR_WORDS 3456
#define XB_SPIN_CAP (1u << 18)
__device__ __forceinline__ unsigned xb_ld(unsigned* p)              { return __hip_atomic_load(p, __ATOMIC_RELAXED, __HIP_MEMORY_SCOPE_AGENT); }
__device__ __forceinline__ unsigned xb_add(unsigned* p, unsigned v) { return __hip_atomic_fetch_add(p, v, __ATOMIC_RELAXED, __HIP_MEMORY_SCOPE_AGENT); }
__device__ __forceinline__ unsigned xb_xcc_id() { return (unsigned)__builtin_amdgcn_s_getreg((3 << 11) | 20) & 0xFu; }
#define XB_SPIN(cond, bar) do { unsigned _sp = 0; while (cond) { __builtin_amdgcn_s_sleep(1); \
    if ((++_sp & 255u) == 0u) { if (xb_ld(&(bar)[XB_TMO])) break; if (_sp > XB_SPIN_CAP) { atomicAdd(&(bar)[XB_TMO], 1u); break; } } } } while (0)
struct XcdBarrier { unsigned* bar; unsigned x; volatile LAS unsigned* st; };
__device__ __forceinline__ XcdBarrier xcd_barrier_post(unsigned* bar, volatile LAS unsigned* st, int tid) {
    XcdBarrier b; b.bar = bar; b.x = xb_xcc_id(); b.st = st;
    if (tid == 0) (void)xb_add(&bar[XB_XCNT(b.x)], 1u);
    return b;
}
__device__ __forceinline__ void xcd_barrier_complete(unsigned* bar, unsigned x, unsigned& nloc, unsigned& nx) {
    const unsigned G = gridDim.x * gridDim.y * gridDim.z;
    unsigned sum, cnt, mine, sp = 0u;
    for (;;) {
        sum = 0u; cnt = 0u; mine = 0u;
#pragma unroll
        for (unsigned j = 0; j < 16; ++j) { const unsigned c = xb_ld(&bar[XB_XCNT(j)]); sum += c; cnt += (c > 0u) ? 1u : 0u; mine = (j == x) ? c : mine; }
        if (sum == G) break;
        __builtin_amdgcn_s_sleep(1);
        if ((++sp & 255u) == 0u) { if (xb_ld(&bar[XB_TMO])) break; if (sp > XB_SPIN_CAP) { atomicAdd(&bar[XB_TMO], 1u); break; } }
    }
    nloc = mine > 0u ? mine : 1u; nx = cnt > 0u ? cnt : 1u;
}
__device__ __forceinline__ void xcd_barrier(const XcdBarrier& b, int tid) {
    asm volatile("s_waitcnt vmcnt(0)" ::: "memory");
    __syncthreads();
    if (tid == 0) {
        unsigned* bar = b.bar; asm volatile("" : "+s"(bar));
        const unsigned bx_ = xb_xcc_id();
        __builtin_amdgcn_s_waitcnt(0);
        unsigned nloc = b.st[0], nx = b.st[1];
        if (nloc == 0u) { xcd_barrier_complete(bar, bx_, nloc, nx); b.st[0] = nloc; b.st[1] = nx; }
        const unsigned old = xb_add(&bar[XB_XSUB(bx_)], 1u);
        const unsigned gen = old / nloc;
        if (old + 1u == (gen + 1u) * nloc) {
            __builtin_amdgcn_fence(__ATOMIC_RELEASE, "agent");
            asm volatile("s_waitcnt vmcnt(0)" ::: "memory");
            const unsigned og = xb_add(&bar[XB_TOP], 1u);
            const unsigned tg = og / nx;
            if (og + 1u == (tg + 1u) * nx) xb_add(&bar[XB_TOPGEN], 1u);
            else XB_SPIN(xb_ld(&bar[XB_TOPGEN]) == tg, bar);
            __builtin_amdgcn_fence(__ATOMIC_ACQUIRE, "agent");
            xb_add(&bar[XB_XGEN(bx_)], 1u);
            asm volatile("s_waitcnt vmcnt(0)" ::: "memory");
        } else {
            XB_SPIN(xb_ld(&bar[XB_XGEN(bx_)]) == gen, bar);
            __builtin_amdgcn_fence(__ATOMIC_ACQUIRE, "agent");
            asm volatile("s_waitcnt vmcnt(0)" ::: "memory");
        }
    }
    __syncthreads();
}

namespace pg8 {
constexpr int BM = 256, BK = 64, HALF = 128, HTB = HALF * BK * 2, STAGE_BYTES = 8 * HTB, NXCD = 8, WGM = 8;
__host__ __device__ __forceinline__ int lds_byte(int r, int c) { const int st = (r >> 4) * 2 + (c >> 5), rr = r & 15, cc = c & 31, ob = rr * 64 + cc * 2; return st * 1024 + (ob ^ (((ob >> 9) & 1) << 5)); }
__host__ __device__ __forceinline__ void stage_rc(int b, int& R, int& C) { const int st = b / 1024, sb = b % 1024, swz = sb ^ (((sb >> 9) & 1) << 5); R = (st >> 1) * 16 + swz / 64; C = (st & 1) * 32 + (swz % 64) / 2; }
__host__ __device__ __forceinline__ int perm32(int rho) { const int n = rho >> 4, i = rho & 15; return 8 * (i >> 2) + 4 * n + (i & 3); }
struct Unit { int pm, pn; };
struct Order {
    int nM, nN, nwg, G, c;
    __device__ __forceinline__ void init(int nM_, int nN_, int G_, int c_) { nM = nM_; nN = nN_; nwg = nM * nN; G = G_; c = c_; }
    __device__ __forceinline__ bool next(int i, Unit& u) const {
        const long L = (long)i * G + c; if (L >= nwg) return false;
        int wgid = (int)L; { const int q = nwg / NXCD, r = nwg % NXCD, xcd = wgid % NXCD, off = wgid / NXCD; wgid = (xcd < r ? xcd * (q + 1) : r * (q + 1) + (xcd - r) * q) + off; }
        const int nig = WGM * nN, gid = wgid / nig, fm = gid * WGM, gsz = (nM - fm) < WGM ? (nM - fm) : WGM;
        u.pm = fm + ((wgid % nig) % gsz); u.pn = (wgid % nig) / gsz; return true;
    }
};
template <class Epi, class Sched, bool ALIGN_EPI>
__device__ __forceinline__ void gemm_phase(LAS unsigned char* lds, int tid_in, const char* Abase, const char* Bbase, int lda, int ldb, int K, const Sched& S, const Epi& E) {
    int tid = tid_in; asm volatile("" : "+v"(tid));
    const int wid = __builtin_amdgcn_readfirstlane(tid >> 6), lane = tid & 63, wr = wid >> 2, wc = wid & 3, fr = lane & 15, fq = lane >> 4;
    const int nt = K / BK;
    unsigned voffA[2], voffB[2];
#pragma unroll
    for (int i = 0; i < 2; ++i) { int R, C; stage_rc(tid * 16 + i * 8192, R, C); const int Rb = Epi::PERM ? ((R & ~31) + perm32(R & 31)) : R;
        voffA[i] = (unsigned)(R * lda + C) * 2u; voffB[i] = (unsigned)(Rb * ldb + C) * 2u; }
    const size_t kstep = (size_t)(BK * 2);
    const size_t hstepA = (size_t)HALF * lda * 2, hstepB = (size_t)HALF * ldb * 2;
    const unsigned ldsw = (unsigned)wid * 1024u;
    const int aoff = lds_byte(wr * 64 + fr, fq * 8), boff = lds_byte(wc * 32 + fr, fq * 8);
#define PG8_SA(b, h) (((b) * 2 + (h)) * HTB)
#define PG8_SB(b, h) ((4 + (b) * 2 + (h)) * HTB)
#define PG8_STAGE(bufoff, gbase, voff) do { _Pragma("unroll") for (int _i = 0; _i < 2; ++_i) \
        __builtin_amdgcn_global_load_lds((const unsigned*)((const char*)(gbase) + (voff)[_i]), (LAS unsigned*)(lds + (bufoff) + ldsw + _i * 8192), 16, 0, 0); } while (0)
#define PG8_LDA(dst, b, h) do { _Pragma("unroll") for (int m = 0; m < 4; ++m) _Pragma("unroll") for (int k = 0; k < 2; ++k) dst[m][k] = *(const LAS bf16x8*)(lds + PG8_SA(b, h) + aoff + m * 2048 + k * 1024); } while (0)
#define PG8_LDB(dst, b, h) do { _Pragma("unroll") for (int n = 0; n < 2; ++n) _Pragma("unroll") for (int k = 0; k < 2; ++k) dst[n][k] = *(const LAS bf16x8*)(lds + PG8_SB(b, h) + boff + n * 2048 + k * 1024); } while (0)
#define PG8_MMA(ai, bj, At, Bt) do { __builtin_amdgcn_s_setprio(1); _Pragma("unroll") for (int m = 0; m < 4; ++m) _Pragma("unroll") for (int n = 0; n < 2; ++n) _Pragma("unroll") for (int k = 0; k < 2; ++k) \
        acc[ai][bj][m][n] = __builtin_amdgcn_mfma_f32_16x16x32_bf16(Bt[n][k], At[m][k], acc[ai][bj][m][n], 0, 0, 0); __builtin_amdgcn_s_setprio(0); } while (0)
#define PG8_WAIT_V(n) asm volatile("s_waitcnt vmcnt(" #n ")" ::: "memory")
#define PG8_WAIT_L(n) asm volatile("s_waitcnt lgkmcnt(" #n ")" ::: "memory")
#define PG8_BAR __builtin_amdgcn_s_barrier()
#define PG8_SCHED __builtin_amdgcn_sched_barrier(0)
    Unit cur, nxt; int ui = 0;
    if (!S.next(0, cur)) return;
    f32x4 acc[2][2][4][2];
#pragma unroll
    for (int a = 0; a < 2; ++a)
#pragma unroll
        for (int b = 0; b < 2; ++b)
#pragma unroll
            for (int m = 0; m < 4; ++m)
#pragma unroll
                for (int n = 0; n < 2; ++n) acc[a][b][m][n] = (f32x4){0.f, 0.f, 0.f, 0.f};
    bf16x8 At[4][2], B0[2][2], B1[2][2];
    const char* cA = Abase + S.aoff(cur); const char* cB = Bbase + S.boff(cur);
    PG8_STAGE(PG8_SB(0, 0), cB, voffB); PG8_STAGE(PG8_SB(0, 1), cB + hstepB, voffB); PG8_STAGE(PG8_SA(0, 0), cA, voffA); PG8_STAGE(PG8_SA(0, 1), cA + hstepA, voffA);
    if (wr == 1) PG8_BAR;
    PG8_WAIT_V(2); PG8_BAR;
    PG8_STAGE(PG8_SB(1, 0), cB + kstep, voffB); PG8_STAGE(PG8_SA(1, 0), cA + kstep, voffA); PG8_STAGE(PG8_SB(1, 1), cB + hstepB + kstep, voffB);
    PG8_WAIT_V(6); PG8_BAR;
    for (;;) {
        const bool has_next = S.next(ui + 1, nxt);
        const char* nA = has_next ? Abase + S.aoff(nxt) : cA; const char* nB = has_next ? Bbase + S.boff(nxt) : cB;
        for (int t = 0; t < nt; t += 2) {
            const bool last = (t == nt - 2);
            const char* a1 = cA + (size_t)(t + 1) * kstep;
            const char* a2 = last ? nA : cA + (size_t)(t + 2) * kstep; const char* b2 = last ? nB : cB + (size_t)(t + 2) * kstep;
            const char* a3 = a2 + kstep; const char* b3 = b2 + kstep;
            PG8_LDB(B0, 0, 0); PG8_LDB(B1, 0, 1); PG8_SCHED; PG8_LDA(At, 0, 0); PG8_STAGE(PG8_SA(1, 1), a1 + hstepA, voffA);
            PG8_WAIT_V(8); PG8_WAIT_L(0); PG8_BAR; PG8_MMA(0, 0, At, B0); PG8_MMA(0, 1, At, B1); PG8_BAR; PG8_SCHED;
            PG8_LDA(At, 0, 1); PG8_STAGE(PG8_SB(0, 0), b2, voffB); PG8_STAGE(PG8_SB(0, 1), b2 + hstepB, voffB); PG8_STAGE(PG8_SA(0, 0), a2, voffA);
            PG8_WAIT_V(8); PG8_WAIT_L(0); PG8_BAR; PG8_MMA(1, 0, At, B0); PG8_MMA(1, 1, At, B1); PG8_BAR; PG8_SCHED;
            PG8_LDB(B0, 1, 0); PG8_LDB(B1, 1, 1); PG8_SCHED; PG8_LDA(At, 1, 0); PG8_STAGE(PG8_SA(0, 1), a2 + hstepA, voffA);
            PG8_WAIT_V(8); PG8_WAIT_L(0); PG8_BAR; PG8_MMA(0, 0, At, B0); PG8_MMA(0, 1, At, B1); PG8_BAR; PG8_SCHED;
            PG8_LDA(At, 1, 1); PG8_STAGE(PG8_SB(1, 0), b3, voffB); PG8_STAGE(PG8_SB(1, 1), b3 + hstepB, voffB); PG8_STAGE(PG8_SA(1, 0), a3, voffA);
            PG8_WAIT_V(8); PG8_WAIT_L(0); PG8_BAR; PG8_MMA(1, 0, At, B0); PG8_MMA(1, 1, At, B1); PG8_BAR; PG8_SCHED;
        }
        if constexpr (ALIGN_EPI) { if (wr == 0) PG8_BAR; }
        { int fr_ = fr, fq_ = fq; asm volatile("" : "+v"(fr_), "+v"(fq_)); E(acc, cur, wr, wc, fr_, fq_); }
        if (!has_next) break;
#pragma unroll
        for (int a = 0; a < 2; ++a)
#pragma unroll
            for (int b = 0; b < 2; ++b)
#pragma unroll
                for (int m = 0; m < 4; ++m)
#pragma unroll
                    for (int n = 0; n < 2; ++n) acc[a][b][m][n] = (f32x4){0.f, 0.f, 0.f, 0.f};
        cur = nxt; cA = nA; cB = nB; ++ui;
        if constexpr (ALIGN_EPI) { if (wr == 1) PG8_BAR; }
    }
    PG8_WAIT_V(0);
    if constexpr (!ALIGN_EPI) { if (wr == 0) PG8_BAR; }
    PG8_BAR;
#undef PG8_SA
#undef PG8_SB
#undef PG8_STAGE
#undef PG8_LDA
#undef PG8_LDB
#undef PG8_MMA
#undef PG8_WAIT_V
#undef PG8_WAIT_L
#undef PG8_BAR
#undef PG8_SCHED
}
}
using pg8::Unit;

__device__ __forceinline__ float row_rstd(const float* rowp, int m) {
    const f32x4* p = (const f32x4*)(rowp + (size_t)m * 32); float s = 0.f;
#pragma unroll
    for (int i = 0; i < 8; ++i) { const f32x4 v = p[i]; s += (v[0] + v[1]) + (v[2] + v[3]); }
    return __builtin_amdgcn_rsqf(s * (1.0f / D) + EPS);
}

__device__ __forceinline__ float row_rstd4(const float* rowp, int m, int fq) {
    const f32x4* p = (const f32x4*)(rowp + (size_t)m * 32 + fq * 8); const f32x4 v0 = p[0], v1 = p[1];
    float s = ((v0[0] + v0[1]) + (v0[2] + v0[3])) + ((v1[0] + v1[1]) + (v1[2] + v1[3]));
    s = xadd<16>(s); s = xadd<32>(s);
    return __builtin_amdgcn_rsqf(s * (1.0f / D) + EPS);
}
struct SchedPlain {
    pg8::Order o; size_t astep, bstep;
    __device__ __forceinline__ bool next(int i, Unit& u) const { return o.next(i, u); }
    __device__ __forceinline__ size_t aoff(const Unit& u) const { return (size_t)u.pm * astep; }
    __device__ __forceinline__ size_t boff(const Unit& u) const { return (size_t)u.pn * bstep; }
};
struct SchedMix {
    pg8::Order o;
    __device__ __forceinline__ bool next(int i, Unit& u) const { return o.next(i, u); }
    __device__ __forceinline__ size_t aoff(const Unit& u) const { return ((size_t)u.pm * 256 * D + (size_t)(u.pn >> 1) * 512) * 2; }
    __device__ __forceinline__ size_t boff(const Unit& u) const { return ((size_t)(u.pn >> 1) * 512 * 512 + (size_t)(u.pn & 1) * 256 * 512) * 2; }
};
struct SchedCmp {
    pg8::Order o;
    __device__ __forceinline__ bool next(int i, Unit& u) const { return o.next(i, u); }
    __device__ __forceinline__ size_t aoff(const Unit& u) const { return (size_t)u.pm * 256 * 2048 * 2; }
    __device__ __forceinline__ size_t boff(const Unit& u) const { const int v = (u.pm < 8) ? 0 : (u.pm < 16) ? 1 : (u.pm < 144) ? 0 : 1; return (size_t)v * 256 * 2048 * 2; }
};

__device__ __forceinline__ f32x4 bf4_to_f32(u32x2 w) { return (f32x4){__uint_as_float(w.x << 16), __uint_as_float(w.x & 0xffff0000u), __uint_as_float(w.y << 16), __uint_as_float(w.y & 0xffff0000u)}; }
struct EpiResid {
    static constexpr bool PERM = false;
    bf16_t* xb; float* fout; float* rowp; const float* colscale; int mlimit;
    __device__ __forceinline__ void operator()(const f32x4 (&acc)[2][2][4][2], const Unit& u, int wr, int wc, int fr, int fq) const {
        const int col0 = u.pn * 256 + wc * 32 + 4 * fq;
        f32x4 cs[2][2];
#pragma unroll
        for (int bj = 0; bj < 2; ++bj)
#pragma unroll
            for (int n = 0; n < 2; ++n) cs[bj][n] = colscale ? *(const f32x4*)(colscale + col0 + bj * 128 + n * 16) : (f32x4){1.f, 1.f, 1.f, 1.f};
#pragma unroll
        for (int ai = 0; ai < 2; ++ai)
#pragma unroll
            for (int m = 0; m < 4; ++m) {
                const int row = u.pm * 256 + ai * 128 + wr * 64 + m * 16 + fr; const size_t off = (size_t)row * D + col0; float ss = 0.f;
                const bool ok = row < mlimit;
#pragma unroll
                for (int bj = 0; bj < 2; ++bj)
#pragma unroll
                    for (int n = 0; n < 2; ++n) {
                        const f32x4 b = ok ? bf4_to_f32(*(const u32x2*)(xb + off + bj * 128 + n * 16)) : (f32x4){0.f, 0.f, 0.f, 0.f};
                        f32x4 v = b + acc[ai][bj][m][n] * cs[bj][n];
                        if (fout) { if (ok) *(f32x4*)(fout + off + bj * 128 + n * 16) = v; }
                        else { u32x2 w; w.x = cvt_pk_bf16(v[0], v[1]); w.y = cvt_pk_bf16(v[2], v[3]); if (ok) *(u32x2*)(xb + off + bj * 128 + n * 16) = w; v = bf4_to_f32(w); }
                        ss += (v[0] * v[0] + v[1] * v[1]) + (v[2] * v[2] + v[3] * v[3]);
                    }
                ss = xadd<16>(ss); ss = xadd<32>(ss);
                if (rowp && fq == 0 && ok) rowp[(size_t)row * 32 + u.pn * 4 + wc] = ss;
                if (m & 1) asm volatile("" ::: "memory");
            }
    }
};
struct EpiF32 {
    static constexpr bool PERM = false;
    const float* rowp; float* out; int ldo; int split; float* out2; int ldo2;
    __device__ __forceinline__ void operator()(const f32x4 (&acc)[2][2][4][2], const Unit& u, int wr, int wc, int fr, int fq) const {
        float* o = out; int ld = ldo; int pn = u.pn; if (pn >= split) { o = out2; ld = ldo2; pn -= split; }
        const int col0 = pn * 256 + wc * 32 + 4 * fq;
#pragma unroll
        for (int ai = 0; ai < 2; ++ai)
#pragma unroll
            for (int m = 0; m < 4; ++m) {
                const int row = u.pm * 256 + ai * 128 + wr * 64 + m * 16 + fr; const float rs = rowp ? row_rstd4(rowp, row, fq) : 1.0f; const size_t off = (size_t)row * ld + col0;
#pragma unroll
                for (int bj = 0; bj < 2; ++bj)
#pragma unroll
                    for (int n = 0; n < 2; ++n) *(f32x4*)(o + off + bj * 128 + n * 16) = acc[ai][bj][m][n] * rs;
            }
    }
};
struct EpiHH {
    static constexpr bool PERM = true;
    const float* rowp; bf16_t* hh; float* convp; float* convs;
    __device__ __forceinline__ void operator()(const f32x4 (&acc)[2][2][4][2], const Unit& u, int wr, int wc, int fr, int fq) const {
        const int colt = wc * 32 + 8 * fq;
#pragma unroll
        for (int ai = 0; ai < 2; ++ai)
#pragma unroll
            for (int m = 0; m < 4; ++m) {
                const int trow = ai * 128 + wr * 64 + m * 16 + fr, row = u.pm * 256 + trow; const float rs = row_rstd4(rowp, row, fq);
                bf16_t* rowptr = hh + (size_t)row * FF2 + u.pn * 256 + colt;
                float* cdst = nullptr;
                if (u.pm == 32) { if (trow < 64 && (trow & 7) >= 6) cdst = convs + ((size_t)(trow >> 3) * 2 + ((trow & 7) - 6)) * FF2; }
                else if ((u.pm & 15) == 15 && trow >= 254) cdst = convp + ((size_t)(u.pm >> 4) * 2 + (trow - 254)) * FF2;
#pragma unroll
                for (int bj = 0; bj < 2; ++bj) {
                    const f32x4 v0 = acc[ai][bj][m][0] * rs, v1 = acc[ai][bj][m][1] * rs;
                    u32x4 w; w.x = cvt_pk_bf16(v0[0], v0[1]); w.y = cvt_pk_bf16(v0[2], v0[3]); w.z = cvt_pk_bf16(v1[0], v1[1]); w.w = cvt_pk_bf16(v1[2], v1[3]);
                    *(u32x4*)(rowptr + bj * 128) = w;
                    if (cdst) { float* c = cdst + bj * FF + u.pn * 128 + colt; *(f32x4*)c = v0; *(f32x4*)(c + 4) = v1; }
                }
            }
    }
};


__device__ __forceinline__ void mini_resid(LAS unsigned char* lds, int tid_in, const bf16_t* A, int lda, const bf16_t* Bt, int ldb, int K, int nb,
                                           bf16_t* xb, float* fout, float* rowp, const float* colscale, int row0) {
    int tid = tid_in; asm volatile("" : "+v"(tid));
    const int wid = __builtin_amdgcn_readfirstlane(tid >> 6), lane = tid & 63, fr = lane & 15, fq = lane >> 4;
    const int kw = K >> 3, kbeg = wid * kw;
    f32x4 acc[4][4];
#pragma unroll
    for (int i = 0; i < 4; ++i)
#pragma unroll
        for (int j = 0; j < 4; ++j) acc[i][j] = (f32x4){0.f, 0.f, 0.f, 0.f};
    const bf16_t* ap = A + (size_t)fr * lda + kbeg + fq * 8; const bf16_t* bp = Bt + (size_t)fr * ldb + kbeg + fq * 8;
#define MINI_STEPS(CH, kk) do { bf16x8 af[CH][4], bf[CH][4]; \
        _Pragma("unroll") for (int c = 0; c < CH; ++c) _Pragma("unroll") for (int i = 0; i < 4; ++i) { af[c][i] = *(const bf16x8*)(ap + (size_t)(16 * i) * lda + (kk) + 32 * c); bf[c][i] = *(const bf16x8*)(bp + (size_t)(16 * i) * ldb + (kk) + 32 * c); } \
        _Pragma("unroll") for (int c = 0; c < CH; ++c) _Pragma("unroll") for (int i = 0; i < 4; ++i) _Pragma("unroll") for (int j = 0; j < 4; ++j) \
            acc[i][j] = __builtin_amdgcn_mfma_f32_16x16x32_bf16(bf[c][j], af[c][i], acc[i][j], 0, 0, 0); } while (0)
    int k = 0;
    for (; k + 128 <= kw; k += 128) MINI_STEPS(4, k);
    for (; k + 64 <= kw; k += 64) MINI_STEPS(2, k);
    for (; k < kw; k += 32) MINI_STEPS(1, k);
#undef MINI_STEPS
    __syncthreads();
    LAS float* part = (LAS float*)lds + wid * 4096;
#pragma unroll
    for (int i = 0; i < 4; ++i)
#pragma unroll
        for (int j = 0; j < 4; ++j) *(LAS f32x4*)(part + (16 * i + fr) * 64 + 16 * j + 4 * fq) = acc[i][j];
    __syncthreads();
    const int row = wid * 8 + (lane >> 3), c8 = (lane & 7) * 8;
    f32x4 s0 = {0.f, 0.f, 0.f, 0.f}, s1 = {0.f, 0.f, 0.f, 0.f};
#pragma unroll
    for (int w = 0; w < 8; ++w) { const LAS float* p = (const LAS float*)lds + w * 4096 + row * 64 + c8; s0 += *(const LAS f32x4*)p; s1 += *(const LAS f32x4*)(p + 4); }
    const int col = nb * 64 + c8; const size_t off = (size_t)(row0 + row) * D + col;
    if (colscale) { s0 = s0 * *(const f32x4*)(colscale + col); s1 = s1 * *(const f32x4*)(colscale + col + 4); }
    const u32x4 xw = *(const u32x4*)(xb + off);
    f32x4 v0 = bf4_to_f32((u32x2){xw.x, xw.y}) + s0, v1 = bf4_to_f32((u32x2){xw.z, xw.w}) + s1;
    if (fout) { *(f32x4*)(fout + off) = v0; *(f32x4*)(fout + off + 4) = v1; }
    else { u32x4 w; w.x = cvt_pk_bf16(v0[0], v0[1]); w.y = cvt_pk_bf16(v0[2], v0[3]); w.z = cvt_pk_bf16(v1[0], v1[1]); w.w = cvt_pk_bf16(v1[2], v1[3]); *(u32x4*)(xb + off) = w;
        v0 = bf4_to_f32((u32x2){w.x, w.y}); v1 = bf4_to_f32((u32x2){w.z, w.w}); }
    float ss = ((v0[0] * v0[0] + v0[1] * v0[1]) + (v0[2] * v0[2] + v0[3] * v0[3])) + ((v1[0] * v1[0] + v1[1] * v1[1]) + (v1[2] * v1[2] + v1[3] * v1[3]));
    ss = xadd<1>(ss); ss = xadd<2>(ss); ss = xadd<4>(ss);
    if (rowp && (lane & 7) == 0) rowp[(size_t)(row0 + row) * 32 + nb] = ss;
    __syncthreads();
}


__device__ __forceinline__ float dpp_ror1(float x) { return __int_as_float(__builtin_amdgcn_update_dpp(0, __float_as_int(x), 0x121, 0xF, 0xF, false)); }
__device__ __forceinline__ float dpp_ror2(float x) { return __int_as_float(__builtin_amdgcn_update_dpp(0, __float_as_int(x), 0x122, 0xF, 0xF, false)); }
__device__ __forceinline__ f32x4 ror1v(f32x4 v) { return (f32x4){dpp_ror1(v[0]), dpp_ror1(v[1]), dpp_ror1(v[2]), dpp_ror1(v[3])}; }
__device__ __forceinline__ f32x4 ror2v(f32x4 v) { return (f32x4){dpp_ror2(v[0]), dpp_ror2(v[1]), dpp_ror2(v[2]), dpp_ror2(v[3])}; }
__device__ __forceinline__ f32x4 sel4(bool c, f32x4 a, f32x4 b) { return c ? a : b; }
template <int N> __device__ __forceinline__ float dpp_shr_prev(float cur, float prev) {
    const int old = __builtin_amdgcn_update_dpp(0, __float_as_int(prev), 0x120 + N, 0xF, 0xF, false);
    return __int_as_float(__builtin_amdgcn_update_dpp(old, __float_as_int(cur), 0x110 + N, 0xF, 0xF, false)); }
template <int N> __device__ __forceinline__ f32x4 shr_prev_v(f32x4 c, f32x4 p) { return (f32x4){dpp_shr_prev<N>(c[0], p[0]), dpp_shr_prev<N>(c[1], p[1]), dpp_shr_prev<N>(c[2], p[2]), dpp_shr_prev<N>(c[3], p[3])}; }
__device__ __forceinline__ u32x2 silu_gate_pk(f32x4 cg, f32x4 cv) { float o[4];
#pragma unroll
    for (int i = 0; i < 4; ++i) o[i] = cg[i] * __builtin_amdgcn_rcpf(1.0f + __builtin_amdgcn_exp2f(-1.4426950408889634f * cg[i])) * cv[i];
    u32x2 w; w.x = cvt_pk_bf16(o[0], o[1]); w.y = cvt_pk_bf16(o[2], o[3]); return w; }
struct EpiConv {
    static constexpr bool PERM = true;
    const float* rowp; bf16_t* act; float* edge; float* convp; float* convs; const float* cw; const float* cb; const float* sconv; LAS float* xch;
    __device__ __forceinline__ void operator()(const f32x4 (&acc)[2][2][4][2], const Unit& u, int wr, int wc, int fr, int fq) const {
        const int jc = wc * 32 + 8 * fq; const bool samp = (u.pm == 32);
        LAS float* rsL = xch + 2048;
        if (wr == 0) { const int tr = wc * 64 + fq * 16 + fr; rsL[tr] = row_rstd(rowp, u.pm * 256 + tr); }
        if (!samp && fr >= 14) {
#pragma unroll
            for (int ai = 0; ai < 2; ++ai)
#pragma unroll
                for (int bj = 0; bj < 2; ++bj)
#pragma unroll
                    for (int n = 0; n < 2; ++n) *(LAS f32x4*)(xch + ((ai * 2 + wr) * 4 + wc) * 128 + (fr - 14) * 64 + bj * 32 + 8 * fq + 4 * n) = acc[ai][bj][3][n];
        }
        LDS_WAIT(); __builtin_amdgcn_s_barrier(); asm volatile("" ::: "memory");
        if (!samp) {
            const bool fix = (u.pm & 15) != 0;
#pragma unroll
            for (int n = 0; n < 2; ++n) {
                const int f = u.pn * 128 + jc + 4 * n;
                const f32x4 wg0 = *(const f32x4*)(cw + f), wg1 = *(const f32x4*)(cw + FF2 + f), wg2 = *(const f32x4*)(cw + 2 * FF2 + f), bg = *(const f32x4*)(cb + f);
                const f32x4 wv0 = *(const f32x4*)(cw + FF + f), wv1 = *(const f32x4*)(cw + FF2 + FF + f), wv2 = *(const f32x4*)(cw + 2 * FF2 + FF + f), bv = *(const f32x4*)(cb + FF + f);
#pragma unroll
                for (int ai = 0; ai < 2; ++ai) {
                    f32x4 hgp = {0.f, 0.f, 0.f, 0.f}, hvp = hgp;
                    if (wr == 1 || ai == 1) { const int sa = wr == 1 ? ai : 0, sw = wr == 1 ? 0 : 1;
                        const LAS float* xp = xch + ((sa * 2 + sw) * 4 + wc) * 128 + (fr >= 14 ? fr - 14 : 0) * 64 + 8 * fq + 4 * n;
                        const float rsp = rsL[sa * 128 + sw * 64 + 48 + (fr >= 14 ? fr : 14)];
                        hgp = *(const LAS f32x4*)xp * rsp; hvp = *(const LAS f32x4*)(xp + 32) * rsp; }
#pragma unroll
                    for (int m = 0; m < 4; ++m) {
                        const float rsv = rsL[ai * 128 + wr * 64 + m * 16 + fr];
                        const f32x4 hg = acc[ai][0][m][n] * rsv, hv = acc[ai][1][m][n] * rsv;
                        const int trow = ai * 128 + wr * 64 + m * 16 + fr; const size_t row = (size_t)u.pm * 256 + trow;
                        const f32x4 cgate = bg + wg0 * shr_prev_v<2>(hg, hgp) + wg1 * shr_prev_v<1>(hg, hgp) + wg2 * hg;
                        const f32x4 cval = bv + wv0 * shr_prev_v<2>(hv, hvp) + wv1 * shr_prev_v<1>(hv, hvp) + wv2 * hv;
                        if (!(fix && trow < 2)) *(u32x2*)(act + row * FF + f) = silu_gate_pk(cgate, cval);
                        if (trow < 2) { float* e = edge + ((size_t)u.pm * 4 + trow) * FF2 + f; *(f32x4*)e = hg; *(f32x4*)(e + FF) = hv; }
                        if (trow >= 254) { float* e = edge + ((size_t)u.pm * 4 + 2 + (trow - 254)) * FF2 + f; *(f32x4*)e = hg; *(f32x4*)(e + FF) = hv;
                            if ((u.pm & 15) == 15) { float* c = convp + ((size_t)(u.pm >> 4) * 2 + (trow - 254)) * FF2 + f; *(f32x4*)c = hg; *(f32x4*)(c + FF) = hv; } }
                        hgp = hg; hvp = hv;
                    }
                }
            }
        } else if (wr == 0) {
            const int t = fr & 7;
#pragma unroll
            for (int n = 0; n < 2; ++n) {
                const int f = u.pn * 128 + jc + 4 * n;
                const f32x4 wg0 = *(const f32x4*)(cw + f), wg1 = *(const f32x4*)(cw + FF2 + f), wg2 = *(const f32x4*)(cw + 2 * FF2 + f), bg = *(const f32x4*)(cb + f);
                const f32x4 wv0 = *(const f32x4*)(cw + FF + f), wv1 = *(const f32x4*)(cw + FF2 + FF + f), wv2 = *(const f32x4*)(cw + 2 * FF2 + FF + f), bv = *(const f32x4*)(cb + FF + f);
#pragma unroll
                for (int m = 0; m < 4; ++m) {
                    const int b = 2 * m + (fr >> 3);
                    const float rsv = rsL[m * 16 + fr];
                    const f32x4 hg = acc[0][0][m][n] * rsv, hv = acc[0][1][m][n] * rsv;
                    const f32x4 cg1 = ror1v(hg), cg2 = ror2v(hg), cv1 = ror1v(hv), cv2 = ror2v(hv);
                    f32x4 p0g = {0.f, 0.f, 0.f, 0.f}, p1g = p0g, p0v = p0g, p1v = p0g;
                    if (t < 2) { const float* sp = sconv + ((size_t)b * 2) * FF2 + f; p0g = *(const f32x4*)sp; p0v = *(const f32x4*)(sp + FF); p1g = *(const f32x4*)(sp + FF2); p1v = *(const f32x4*)(sp + FF2 + FF); }
                    const f32x4 g1 = sel4(t >= 1, cg1, p1g), g2 = sel4(t >= 2, cg2, sel4(t == 1, p1g, p0g)), v1 = sel4(t >= 1, cv1, p1v), v2 = sel4(t >= 2, cv2, sel4(t == 1, p1v, p0v));
                    const f32x4 cgate = bg + wg0 * g2 + wg1 * g1 + wg2 * hg, cval = bv + wv0 * v2 + wv1 * v1 + wv2 * hv;
                    *(u32x2*)(act + (size_t)(MP + 16 * m + fr) * FF + f) = silu_gate_pk(cgate, cval);
                    if (t >= 6) { float* c = convs + ((size_t)b * 2 + (t - 6)) * FF2 + f; *(f32x4*)c = hg; *(f32x4*)(c + FF) = hv; }
                }
            }
        }
    }
};
__device__ __forceinline__ void act_fixup(int pm, int tid, const float* edge, bf16_t* act, const float* cw, const float* cb) {
    if ((pm & 15) != 0 && pm < 32) {
        const float* E = edge + (size_t)pm * 4 * FF2; const float* Ep = E - (size_t)4 * FF2;
        for (int f = tid; f < FF; f += NTHR) {
            const float a2g = Ep[2 * FF2 + f], a3g = Ep[3 * FF2 + f], e0g = E[f], e1g = E[FF2 + f];
            const float a2v = Ep[2 * FF2 + FF + f], a3v = Ep[3 * FF2 + FF + f], e0v = E[FF + f], e1v = E[FF2 + FF + f];
            const float w0g = cw[f], w1g = cw[FF2 + f], w2g = cw[2 * FF2 + f], bg = cb[f], w0v = cw[FF + f], w1v = cw[FF2 + FF + f], w2v = cw[2 * FF2 + FF + f], bv = cb[FF + f];
            const float cg0 = bg + w0g * a2g + w1g * a3g + w2g * e0g, cv0 = bv + w0v * a2v + w1v * a3v + w2v * e0v;
            const float cg1 = bg + w0g * a3g + w1g * e0g + w2g * e1g, cv1 = bv + w0v * a3v + w1v * e0v + w2v * e1v;
            act[(size_t)(pm * 256) * FF + f] = (bf16_t)(cvt_pk_bf16(cg0 / (1.0f + __expf(-cg0)) * cv0, 0.f) & 0xffffu);
            act[(size_t)(pm * 256 + 1) * FF + f] = (bf16_t)(cvt_pk_bf16(cg1 / (1.0f + __expf(-cg1)) * cv1, 0.f) & 0xffffu);
        }
    }
}

struct Args { const void* in[25]; float* out; unsigned char* ws; };
struct Frame {
    LAS unsigned char* lds; int tid, lane, wave, vcu, G;
};

__device__ __forceinline__ void tr_item(const float* W, int ldw, int k0, int nsrc0, int nvalid, const float* kscale, bf16_t* WT, int ldt, int ndst0, LAS float* scr, int lane) {
    const int r = lane >> 4, c4 = (lane & 15) * 4; const bool cv = nsrc0 + c4 < nvalid;
    f32x4 v[16];
#pragma unroll
    for (int i = 0; i < 16; ++i) v[i] = cv ? *(const f32x4*)(W + (size_t)(k0 + 4 * i + r) * ldw + nsrc0 + c4) : (f32x4){0.f, 0.f, 0.f, 0.f};
    if (kscale) {
#pragma unroll
        for (int i = 0; i < 16; ++i) v[i] = v[i] * kscale[k0 + 4 * i + r]; }
#pragma unroll
    for (int i = 0; i < 16; ++i) *(LAS f32x4*)(scr + (4 * i + r) * 64 + c4) = v[i];
    LDS_WAIT(); asm volatile("" ::: "memory");
    bf16_t* dst = WT + (size_t)(ndst0 + lane) * ldt + k0;
#pragma unroll
    for (int j = 0; j < 8; ++j) { const LAS float* p = scr + (8 * j) * 64 + lane;
        u32x4 o; o.x = cvt_pk_bf16(p[0], p[64]); o.y = cvt_pk_bf16(p[128], p[192]); o.z = cvt_pk_bf16(p[256], p[320]); o.w = cvt_pk_bf16(p[384], p[448]);
        *(u32x4*)(dst + 8 * j) = o; }
    LDS_WAIT(); asm volatile("" ::: "memory");
}

__device__ __forceinline__ void p0_prologue(const Args& a, const Frame& F) {
    unsigned char* ws = a.ws;
    LAS float* scr = (LAS float*)(F.lds + F.wave * 16384);
    const int gw = F.vcu * NWAVES + F.wave, NGW = F.G * NWAVES, lane = F.lane;
    const float* ln_mix = (const float*)a.in[8]; const float* ln_ffn = (const float*)a.in[9];
    constexpr int I_POOL = 8 * 8 * 8, I_WIN = 32 * 176, I_WOUT = 88 * 32, I_WKV = 32 * 48, I_WQG = 32 * 36, I_WO = 32 * 32, I_W1 = 32 * 2, I_W2 = 2 * 2;
    constexpr int NITEMS = I_POOL + 4 * I_WIN + 4 * I_WOUT + I_WKV + 2 * I_WQG + 2 * I_WO + 4 * I_W1 + 2 * I_W2;
    for (int it = gw; it < NITEMS; it += NGW) {
        int r = it;
        if (r < I_POOL) { const int mat = r >> 6, q = r & 63, kb = q >> 3, nb = q & 7;
            tr_item((const float*)a.in[10] + (size_t)mat * 512 * 512, 512, kb * 64, nb * 64, 512, nullptr, (bf16_t*)(ws + WS_WPOOL) + (size_t)mat * 512 * 512, 512, nb * 64, scr, lane); continue; } r -= I_POOL;
        if (r < 4 * I_WIN) { const int l = r / I_WIN, q = r % I_WIN, kb = q / 176, nb = q % 176; const int ns = nb * 64;
            const int f = ns < FF ? ns : ns - FF; const int nd = (f >> 7) * 256 + (ns < FF ? 0 : 128) + (f & 127);
            tr_item((const float*)a.in[21] + (size_t)l * D * FF2, FF2, kb * 64, ns, FF2, ln_ffn + l * D, (bf16_t*)(ws + WS_WIN) + (size_t)l * FF2 * D, D, nd, scr, lane); continue; } r -= 4 * I_WIN;
        if (r < 4 * I_WOUT) { const int l = r / I_WOUT, q = r % I_WOUT, kb = q >> 5, nb = q & 31;
            tr_item((const float*)a.in[24] + (size_t)l * FF * D, D, kb * 64, nb * 64, D, nullptr, (bf16_t*)(ws + WS_WOUT) + (size_t)l * D * FF, FF, nb * 64, scr, lane); continue; } r -= 4 * I_WOUT;
        if (r < I_WKV) { const int kb = r / 48, nb = r % 48;
            tr_item((const float*)a.in[13], KVW, kb * 64, nb * 64, KVW, (const float*)a.in[12], (bf16_t*)(ws + WS_WKVQG), D, nb * 64, scr, lane); continue; } r -= I_WKV;
        if (r < 2 * I_WQG) { const int j = r / I_WQG, q = r % I_WQG, kb = q / 36, nb = q % 36;
            bf16_t* dst = j == 0 ? (bf16_t*)(ws + WS_WKVQG) + (size_t)KVW * D : (bf16_t*)(ws + WS_WQG1);
            tr_item((const float*)a.in[18] + (size_t)j * D * QGW, QGW, kb * 64, nb * 64, QGW, ln_mix + (2 + j) * D, dst, D, nb * 64, scr, lane); continue; } r -= 2 * I_WQG;
        if (r < 2 * I_WO) { const int j = r / I_WO, q = r % I_WO, kb = q >> 5, nb = q & 31;
            tr_item((const float*)a.in[20] + (size_t)j * D * D, D, kb * 64, nb * 64, D, nullptr, (bf16_t*)(ws + WS_WO) + (size_t)j * D * D, D, nb * 64, scr, lane); continue; } r -= 2 * I_WO;
        if (r < 4 * I_W1) { const int vh = r / I_W1, q = r % I_W1, kb = q >> 1, nb = q & 1; const int v = vh >> 1, half = vh & 1;
            tr_item((const float*)a.in[15] + ((size_t)(v * 32 + half * 16) * 128) * 128, 128, kb * 64, nb * 64, 128, nullptr, (bf16_t*)(ws + WS_W1CAT) + (size_t)v * 256 * 2048, 2048, half * 128 + nb * 64, scr, lane); continue; } r -= 4 * I_W1;
        { const int v = r / I_W2, q = r % I_W2, kb = q >> 1, nb = q & 1;
            tr_item((const float*)a.in[17] + (size_t)v * 128 * 128, 128, kb * 64, nb * 64, 128, nullptr, (bf16_t*)(ws + WS_W2T) + (size_t)v * 128 * 128, 128, nb * 64, scr, lane); }
    }
    for (int it = gw; it < 256; it += NGW) { const int v = it >> 7, h = it & 127; const float* pos = (const float*)a.in[16] + (size_t)v * 4096; const float* w1 = (const float*)a.in[15] + (size_t)v * 4096 * 128 + h;
        float s = 0.f; for (int i = lane; i < 4096; i += 64) s += pos[i] * w1[(size_t)i * 128];
        s = wave_sum(s); if (lane == 0) ((float*)(ws + WS_CBIAS))[it] = s; }
    { bf16_t* XBp = (bf16_t*)(ws + WS_XB); float* rowp = (float*)(ws + WS_ROWP);
      for (int m = gw; m < MR; m += NGW) { const float* src = m < MP ? (const float*)a.in[0] + (size_t)m * D : (const float*)a.in[1] + (size_t)(m - MP) * D;
          float s = 0.f;
#pragma unroll
          for (int j = 0; j < 8; ++j) { const f32x4 v = *((const f32x4*)src + lane + 64 * j); u32x2 w; w.x = cvt_pk_bf16(v[0], v[1]); w.y = cvt_pk_bf16(v[2], v[3]);
              *((u32x2*)(XBp + (size_t)m * D) + lane + 64 * j) = w; const f32x4 r = bf4_to_f32(w); s += (r[0] * r[0] + r[1] * r[1]) + (r[2] * r[2] + r[3] * r[3]); }
          s = wave_sum(s); if (lane < 32) rowp[(size_t)m * 32 + lane] = lane == 0 ? s : 0.f; } }
    { const float* cache = (const float*)a.in[2]; const int* pt = (const int*)a.in[4]; bf16_t* ACMP = (bf16_t*)(ws + WS_ACMP);
      for (int it = gw; it < NBS * 1024; it += NGW) { const int b = it >> 10, n = it & 1023; const int page = pt[b * 128 + (n >> 3)];
          const float* src = cache + ((size_t)page * 128 + (n & 7) * 16) * 1024;
#pragma unroll 8
          for (int s = 0; s < 16; ++s)
#pragma unroll
              for (int q = 0; q < 4; ++q) { const f32x4 v = __builtin_nontemporal_load((const f32x4*)(src + s * 1024 + q * 256) + lane); const int hq = q * 2 + (lane >> 5), vv = hq >> 2, g = hq & 3, d = (lane & 31) * 4;
                  u32x2 w; w.x = cvt_pk_bf16(v[0], v[1]); w.y = cvt_pk_bf16(v[2], v[3]);
                  *(u32x2*)(ACMP + ((size_t)CMP_ROW_S0 + (size_t)vv * 32768 + (size_t)(b * 4 + g) * 1024 + n) * 2048 + s * 128 + d) = w; } } }
    { const float* st = (const float*)a.in[5]; bf16_t* KW = (bf16_t*)(ws + WS_KWINS); bf16_t* VW = (bf16_t*)(ws + WS_VWINS); float* ow = a.out + O_WINS;
      for (int it = gw; it < NBS * 512; it += NGW) { const int b = it >> 9, i = it & 511; const float* src = st + (size_t)it * 1024;
#pragma unroll
          for (int q = 0; q < 4; ++q) { const f32x4 v = *((const f32x4*)(src + q * 256) + lane); const int hq = q * 2 + (lane >> 5), vv = hq >> 2, g = hq & 3, d = (lane & 31) * 4;
              u32x2 w; w.x = cvt_pk_bf16(v[0], v[1]); w.y = cvt_pk_bf16(v[2], v[3]);
              *(u32x2*)((vv ? VW : KW) + ((size_t)(b * 4 + g) * 576 + i) * 128 + d) = w;
              if (i >= 8) *((f32x4*)(ow + ((size_t)b * 512 + (i - 8)) * 1024 + q * 256) + lane) = v; } } }
    { const int gt = gw * 64 + lane, NGT = NGW * 64; const u32x4 z = {0u, 0u, 0u, 0u};
      for (int i = gt; i < (int)(MiB / 16); i += NGT) { *((u32x4*)(ws + WS_KCP) + i) = z; *((u32x4*)(ws + WS_KSELNS) + i) = z; }
      for (int i = gt; i < 32 * 16; i += NGT) { const int bg = i >> 4, c = i & 15; *((u32x4*)(ws + WS_KCS + ((size_t)bg * 1024 + 1023) * 256) + c) = z; *((u32x4*)(ws + WS_VCS + ((size_t)bg * 1024 + 1023) * 256) + c) = z; }
      for (int i = gt; i < 32 * 56 * 16; i += NGT) { const int bg = i / (56 * 16), r = i % (56 * 16); *((u32x4*)(ws + WS_KWINS + ((size_t)bg * 576 + 520) * 256) + r) = z; *((u32x4*)(ws + WS_VWINS + ((size_t)bg * 576 + 520) * 256) + r) = z; } }
}

__device__ __forceinline__ void pool_pass(const Args& a, const Frame& F, int l) {
    unsigned char* ws = a.ws; const bf16_t* X = (const bf16_t*)(ws + WS_XB); const float* rowp = (const float*)(ws + WS_ROWP + (size_t)(2 * l) * ROWP_STRIDE);
    const float* gain = (const float*)a.in[8] + l * D; bf16_t* PO = (bf16_t*)(ws + WS_POOLED);
    LAS float* ctx = (LAS float*)F.lds; LAS float* rs = (LAS float*)(F.lds + 47 * 512 * 4);
    const int tid = F.tid;
    constexpr int NUP = (MP / 32) * 4, NU = NUP + NBS * 4;
    for (int u = F.vcu; u < NU; u += F.G) {
        __syncthreads();
        if (u < NUP) {
            const int g = u & 3, rt = u >> 2, b = rt >> 7, t0 = (rt & 127) * 32, w = 2 << g;
            const int c4 = tid & 127, rr = tid >> 7; f32x4 xv[12];
#pragma unroll
            for (int i = 0; i < 12; ++i) { const int r = rr + 4 * i, t = t0 - 15 + r; xv[i] = (r < 47 && t >= 0) ? bf4_to_f32(*((const u32x2*)(X + (size_t)(b * SEQ + t) * D + g * 512) + c4)) : (f32x4){0.f, 0.f, 0.f, 0.f}; }
            const f32x4 gv = *((const f32x4*)(gain + g * 512) + c4);
            if (tid < 47) { const int t = t0 - 15 + tid; rs[tid] = t >= 0 ? row_rstd(rowp, b * SEQ + t) : 0.f; }
            __syncthreads();
#pragma unroll
            for (int i = 0; i < 12; ++i) { const int r = rr + 4 * i; if (r < 47) *((LAS f32x4*)(ctx + r * 512) + c4) = xv[i] * rs[r] * gv; }
            __syncthreads();
            { const int cp = tid & 255, half = tid >> 8, r0 = 15 + half * 16; float s0 = 0.f, s1 = 0.f;
              for (int i = 1; i < w; ++i) { const f32x2 v = *(const LAS f32x2*)(ctx + (r0 - i) * 512 + 2 * cp); s0 += v[0]; s1 += v[1]; }
              for (int i = 0; i < 16; ++i) { const int r = r0 + i, t = t0 + half * 16 + i; const f32x2 h = *(const LAS f32x2*)(ctx + r * 512 + 2 * cp); s0 += h[0]; s1 += h[1];
                  const float inv = 1.0f / (float)(t + 1 < w ? t + 1 : w);
                  *(unsigned*)(PO + (size_t)(b * SEQ + t) * D + g * 512 + 2 * cp) = cvt_pk_bf16(s0 * inv - h[0], s1 * inv - h[1]);
                  const f32x2 o = *(const LAS f32x2*)(ctx + (r - w + 1) * 512 + 2 * cp); s0 -= o[0]; s1 -= o[1]; } }
            if (t0 == SEQ - 32) { float* op = a.out + O_POOLP + ((size_t)(l * NBP + b) * 15) * D + g * 512;
                for (int i = tid; i < 15 * 512; i += NTHR) { const int r = i >> 9, c = i & 511; op[(size_t)r * D + c] = ctx[(32 + r) * 512 + c]; } }
        } else {
            const int us = u - NUP, g = us & 3, b = us >> 2, w = 2 << g; const float* sp = (const float*)a.in[6] + ((size_t)(l * NBS + b) * 15) * D + g * 512;
            if (tid < 8) rs[tid] = row_rstd(rowp, MP + b * 8 + tid);
            __syncthreads();
            for (int i = tid; i < 23 * 512; i += NTHR) { const int r = i >> 9, c = i & 511;
                ctx[i] = r < 15 ? sp[(size_t)r * D + c] : bf2f(X[(size_t)(MP + b * 8 + r - 15) * D + g * 512 + c]) * rs[r - 15] * gain[g * 512 + c]; }
            __syncthreads();
            { const int c = tid; const float inv = 1.0f / (float)w;
              for (int t = 0; t < 8; ++t) { float s = 0.f; for (int i = 0; i < w; ++i) s += ctx[(15 + t - i) * 512 + c];
                  PO[(size_t)(MP + b * 8 + t) * D + g * 512 + c] = (bf16_t)(cvt_pk_bf16(s * inv - ctx[(15 + t) * 512 + c], 0.f) & 0xffffu); } }
            { float* op = a.out + O_POOLS + ((size_t)(l * NBS + b) * 15) * D + g * 512;
              for (int i = tid; i < 15 * 512; i += NTHR) { const int r = i >> 9, c = i & 511; op[(size_t)r * D + c] = ctx[(8 + r) * 512 + c]; } }
        }
    }
    __syncthreads();
}

__device__ __forceinline__ void convgate_pass(const Args& a, const Frame& F, int l) {
    unsigned char* ws = a.ws; const bf16_t* HH = (const bf16_t*)(ws + WS_HH); bf16_t* ACT = (bf16_t*)(ws + WS_ACT);
    const float* cw = (const float*)a.in[22] + (size_t)l * 3 * FF2; const float* cb = (const float*)a.in[23] + (size_t)l * FF2; const float* sc = (const float*)a.in[7] + (size_t)l * NBS * 2 * FF2;
    const int gw = F.vcu * NWAVES + F.wave, NGW = F.G * NWAVES, lane = F.lane;
    constexpr int NCH_P = MP / 16, NIT = (NCH_P + NBS) * 11;
    for (int it = gw; it < NIT; it += NGW) {
        const int fg = it % 11, ch = it / 11; const int f0 = fg * 512 + lane * 8, pn = f0 >> 7, j0 = f0 & 127;
        const bool samp = ch >= NCH_P; const int bs = ch - NCH_P; const int m0 = samp ? MP + bs * 8 : ch * 16, nrow = samp ? 8 : 16; const bool seq_start = samp || ((ch & 255) == 0);
        float wg[3][8], wv[3][8], bg[8], bv[8];
#pragma unroll
        for (int k = 0; k < 3; ++k) { const f32x4 a0 = *(const f32x4*)(cw + k * FF2 + f0), a1 = *(const f32x4*)(cw + k * FF2 + f0 + 4), c0 = *(const f32x4*)(cw + k * FF2 + FF + f0), c1 = *(const f32x4*)(cw + k * FF2 + FF + f0 + 4);
#pragma unroll
            for (int i = 0; i < 4; ++i) { wg[k][i] = a0[i]; wg[k][4 + i] = a1[i]; wv[k][i] = c0[i]; wv[k][4 + i] = c1[i]; } }
        { const f32x4 a0 = *(const f32x4*)(cb + f0), a1 = *(const f32x4*)(cb + f0 + 4), c0 = *(const f32x4*)(cb + FF + f0), c1 = *(const f32x4*)(cb + FF + f0 + 4);
#pragma unroll
          for (int i = 0; i < 4; ++i) { bg[i] = a0[i]; bg[4 + i] = a1[i]; bv[i] = c0[i]; bv[4 + i] = c1[i]; } }
        float g2[8], g1[8], v2[8], v1[8];
        const size_t colg = (size_t)pn * 256 + j0;
        if (seq_start) {
            if (samp) { const float* p0 = sc + ((size_t)bs * 2 + 0) * FF2, *p1 = sc + ((size_t)bs * 2 + 1) * FF2;
#pragma unroll
                for (int i = 0; i < 8; ++i) { g2[i] = p0[f0 + i]; v2[i] = p0[FF + f0 + i]; g1[i] = p1[f0 + i]; v1[i] = p1[FF + f0 + i]; } }
            else {
#pragma unroll
                for (int i = 0; i < 8; ++i) { g2[i] = 0.f; g1[i] = 0.f; v2[i] = 0.f; v1[i] = 0.f; } }
        } else {
            const bf16x8 a2 = *(const bf16x8*)(HH + (size_t)(m0 - 2) * FF2 + colg), a1 = *(const bf16x8*)(HH + (size_t)(m0 - 1) * FF2 + colg);
            const bf16x8 c2 = *(const bf16x8*)(HH + (size_t)(m0 - 2) * FF2 + colg + 128), c1 = *(const bf16x8*)(HH + (size_t)(m0 - 1) * FF2 + colg + 128);
#pragma unroll
            for (int i = 0; i < 8; ++i) { g2[i] = bf2f((bf16_t)a2[i]); g1[i] = bf2f((bf16_t)a1[i]); v2[i] = bf2f((bf16_t)c2[i]); v1[i] = bf2f((bf16_t)c1[i]); }
        }
        for (int r = 0; r < nrow; ++r) {
            const bf16x8 ag = *(const bf16x8*)(HH + (size_t)(m0 + r) * FF2 + colg), av = *(const bf16x8*)(HH + (size_t)(m0 + r) * FF2 + colg + 128);
            float o[8];
#pragma unroll
            for (int i = 0; i < 8; ++i) { const float hg = bf2f((bf16_t)ag[i]), hv = bf2f((bf16_t)av[i]);
                const float cg = bg[i] + wg[0][i] * g2[i] + wg[1][i] * g1[i] + wg[2][i] * hg, cv = bv[i] + wv[0][i] * v2[i] + wv[1][i] * v1[i] + wv[2][i] * hv;
                o[i] = cg / (1.0f + __expf(-cg)) * cv; g2[i] = g1[i]; g1[i] = hg; v2[i] = v1[i]; v1[i] = hv; }
            u32x4 w; w.x = cvt_pk_bf16(o[0], o[1]); w.y = cvt_pk_bf16(o[2], o[3]); w.z = cvt_pk_bf16(o[4], o[5]); w.w = cvt_pk_bf16(o[6], o[7]);
            *(u32x4*)(ACT + (size_t)(m0 + r) * FF + f0) = w;
        }
    }
}

__device__ __forceinline__ void kvpost_pass(const Args& a, const Frame& F) {
    unsigned char* ws = a.ws; const float* KV = (const float*)(ws + WS_KV); const float* knorm = (const float*)a.in[14];
    const int gw = F.vcu * NWAVES + F.wave, NGW = F.G * NWAVES, lane = F.lane, hl = lane >> 5, d4 = (lane & 31) * 4;
    bf16_t* ACMP = (bf16_t*)(ws + WS_ACMP);
    const f32x4 kn1 = *(const f32x4*)(knorm + 128 + d4), kn2 = *(const f32x4*)(knorm + 256 + d4);
    for (int m = gw; m < MR; m += NGW) {
        const bool samp = m >= MP; const int b = samp ? (m - MP) >> 3 : m >> 12, t = samp ? (m - MP) & 7 : m & (SEQ - 1);
        f32x4 rv[12];
#pragma unroll
        for (int j = 0; j < 12; ++j) rv[j] = *((const f32x4*)(KV + (size_t)m * KVW + j * 256) + lane);
#pragma unroll
        for (int j = 0; j < 12; ++j) {
            const int e = j * 2 + hl, br = j >> 2, v = (e >> 2) & 1, g = e & 3, bg = b * 4 + g;
            f32x4 raw = rv[j];
            if (br > 0 && v == 0) { float ss = (raw[0] * raw[0] + raw[1] * raw[1]) + (raw[2] * raw[2] + raw[3] * raw[3]);
                ss = xadd<1>(ss); ss = xadd<2>(ss); ss = xadd<4>(ss); ss = xadd<8>(ss); ss = xadd<16>(ss);
                const float rstd = 1.0f / sqrtf(ss * (1.0f / 128.0f) + EPS); raw = raw * rstd * (br == 1 ? kn1 : kn2); }
            u32x2 pk; pk.x = cvt_pk_bf16(raw[0], raw[1]); pk.y = cvt_pk_bf16(raw[2], raw[3]); const size_t oe = (size_t)(v * 4 + g) * 128 + d4;
            if (br == 0) {
                if (!samp) { *(f32x4*)(a.out + O_CMPP + (size_t)m * 1024 + oe) = raw;
                    *(u32x2*)(ACMP + ((size_t)v * 2048 + (size_t)bg * 256 + (t >> 4)) * 2048 + (t & 15) * 128 + d4) = pk; }
                else *(f32x4*)(a.out + O_CMPS + (size_t)(m - MP) * 1024 + oe) = raw;
            } else if (br == 1) {
                if (!samp) { *(f32x4*)(a.out + O_SELP + (size_t)m * 1024 + oe) = raw;
                    *(u32x2*)((bf16_t*)(ws + (v ? WS_VSEL : WS_KSEL)) + ((size_t)bg * SEQ + t) * 128 + d4) = pk; }
                else { *(f32x4*)(a.out + O_SELS + (size_t)(m - MP) * 1024 + oe) = raw;
                    *(u32x2*)((bf16_t*)(ws + (v ? WS_VSELNS : WS_KSELNS)) + ((size_t)bg * 64 + t) * 128 + d4) = pk; }
            } else {
                if (!samp) { *(u32x2*)((bf16_t*)(ws + (v ? WS_VWIN : WS_KWIN)) + ((size_t)bg * SEQ + t) * 128 + d4) = pk;
                    if (t >= SEQ - 512) *(f32x4*)(a.out + O_WINP + ((size_t)b * 512 + (t - (SEQ - 512))) * 1024 + oe) = raw; }
                else { *(u32x2*)((bf16_t*)(ws + (v ? WS_VWINS : WS_KWINS)) + ((size_t)bg * 576 + 512 + t) * 128 + d4) = pk;
                    *(f32x4*)(a.out + O_WINS + ((size_t)b * 512 + 504 + t) * 1024 + oe) = raw; }
            }
        }
    }
}

__device__ __forceinline__ int crow(int r, int hi) { return (r & 3) + 8 * (r >> 2) + 4 * hi; }
__device__ __forceinline__ float gelu_tanh(float x) { const float u = 0.7978845608028654f * (x + 0.044715f * x * x * x); const float e = __expf(2.0f * u); const float th = 1.0f - 2.0f / (1.0f + e); return 0.5f * x * (1.0f + th); }
__device__ __forceinline__ void cmppost_pass(const Args& a, const Frame& F) {
    unsigned char* ws = a.ws; const float* P = (const float*)(ws + WS_PCMP); const bf16_t* W2T = (const bf16_t*)(ws + WS_W2T); const float* bias = (const float*)(ws + WS_CBIAS);
    const float* kn0 = (const float*)a.in[14];
    const int gw = F.vcu * NWAVES + F.wave, NGW = F.G * NWAVES, lane = F.lane, r32 = lane & 31, hi = lane >> 5;
    constexpr int NIT_P = 2 * 4 * 2 * 8, NIT = NIT_P + 8 * 4 * 2 * 32;
    for (int it = gw; it < NIT; it += NGW) {
        int sgb, g, v, ch, NC, pitch; size_t prow0; bf16_t* dst;
        if (it < NIT_P) { ch = it & 7; v = (it >> 3) & 1; g = (it >> 4) & 3; sgb = it >> 6; NC = NCP; pitch = 256; prow0 = (size_t)v * 2048 + (size_t)(sgb * 4 + g) * 256;
            dst = (bf16_t*)(ws + (v ? WS_VCP : WS_KCP)) + (size_t)(sgb * 4 + g) * 256 * 128; }
        else { const int q = it - NIT_P; ch = q & 31; v = (q >> 5) & 1; g = (q >> 6) & 3; sgb = q >> 8; NC = NCS; pitch = 1024; prow0 = (size_t)CMP_ROW_S0 + (size_t)v * 32768 + (size_t)(sgb * 4 + g) * 1024;
            dst = (bf16_t*)(ws + (v ? WS_VCS : WS_KCS)) + (size_t)(sgb * 4 + g) * 1024 * 128; }
        const int i = ch * 32 + r32; const bool iv = i < NC;
        bf16x8 af[8];
#pragma unroll
        for (int ks = 0; ks < 8; ++ks) { const int h0 = ks * 16 + hi * 8; float hv[8];
            if (iv) { const f32x4 p0 = *(const f32x4*)(P + (prow0 + i) * 256 + h0), p1 = *(const f32x4*)(P + (prow0 + i) * 256 + h0 + 4);
                const f32x4 q0 = *(const f32x4*)(P + (prow0 + i + 1) * 256 + 128 + h0), q1 = *(const f32x4*)(P + (prow0 + i + 1) * 256 + 128 + h0 + 4);
                const f32x4 b0 = *(const f32x4*)(bias + v * 128 + h0), b1 = *(const f32x4*)(bias + v * 128 + h0 + 4);
#pragma unroll
                for (int e = 0; e < 4; ++e) { hv[e] = gelu_tanh(p0[e] + q0[e] + b0[e]); hv[4 + e] = gelu_tanh(p1[e] + q1[e] + b1[e]); } }
            else {
#pragma unroll
                for (int e = 0; e < 8; ++e) hv[e] = 0.f; }
            u32x4 w; w.x = cvt_pk_bf16(hv[0], hv[1]); w.y = cvt_pk_bf16(hv[2], hv[3]); w.z = cvt_pk_bf16(hv[4], hv[5]); w.w = cvt_pk_bf16(hv[6], hv[7]); af[ks] = __builtin_bit_cast(bf16x8, w); }
        f32x16 o[4];
#pragma unroll
        for (int d0 = 0; d0 < 4; ++d0) { o[d0] = (f32x16){};
#pragma unroll
            for (int ks = 0; ks < 8; ++ks) { const bf16x8 bfr = *(const bf16x8*)(W2T + (size_t)v * 128 * 128 + (size_t)(32 * d0 + r32) * 128 + ks * 16 + hi * 8);
                o[d0] = __builtin_amdgcn_mfma_f32_32x32x16_bf16(af[ks], bfr, o[d0], 0, 0, 0); } }
#pragma unroll
        for (int r = 0; r < 16; ++r) {
            float sc = 1.0f;
            if (v == 0) { float ss = o[0][r] * o[0][r] + o[1][r] * o[1][r] + o[2][r] * o[2][r] + o[3][r] * o[3][r];
                ss = xadd<1>(ss); ss = xadd<2>(ss); ss = xadd<4>(ss); ss = xadd<8>(ss); ss = xadd<16>(ss);
                sc = 1.0f / sqrtf(ss * (1.0f / 128.0f) + EPS); }
            const int ir = ch * 32 + crow(r, hi);
            if (ir < NC) {
#pragma unroll
                for (int d0 = 0; d0 < 4; ++d0) { const int d = 32 * d0 + r32; const float val = v == 0 ? o[d0][r] * sc * kn0[d] : o[d0][r];
                    dst[(size_t)ir * 128 + d] = (bf16_t)(cvt_pk_bf16(val, 0.f) & 0xffffu); } }
        }
    }
}

namespace nsa {
#define KSWZ(row, colB) ((row) * 256 + ((colB) ^ (((row) & 7) << 4)))
constexpr float LOG2E = 1.4426950408889634f;
constexpr int L_K = 0, L_V = 16384, L_BUF = 32768  , L_PQ = 65536, L_SELM = 131072 + 1024, L_WUN = L_SELM + 64 * 5 * 8, L_WSF = L_WUN + 8 * 5 * 8, L_END = L_WSF + 8 * 64 * 4;
static_assert(L_END <= LDS_BYTES, "attention LDS");
__device__ __forceinline__ int v_st(int k, int c) { const int kk = (k & ~0xC) | ((k & 4) << 1) | ((k & 8) >> 1); return ((kk >> 3) * 4 + (c >> 5)) * 512 + ((kk & 7) * 32 + (c & 31)) * 2; }
__device__ __forceinline__ int v_rd_base(int lane) { return ((lane & 3) << 3) | (((lane >> 2) & 3) << 6) | (((lane >> 4) & 1) << 5) | (((lane >> 5) & 1) << 8); }
constexpr int v_rd_off(int d0, int ks, int half) { return d0 * 512 + ks * 4096 + half * 2048; }
template <int OFF> __device__ __forceinline__ s16x4 tr_read(int vb) { s16x4 r; asm volatile("ds_read_b64_tr_b16 %0, %1 offset:%2" : "=&v"(r) : "v"(vb), "i"(OFF) : "memory"); return r; }
template <int D0> __device__ __forceinline__ void pv_one(f32x16& od, int vb, bf16x8 pa0, bf16x8 pa1, bf16x8 pa2, bf16x8 pa3) {
    const s16x4 l0 = tr_read<v_rd_off(D0, 0, 0)>(vb), h0 = tr_read<v_rd_off(D0, 0, 1)>(vb), l1 = tr_read<v_rd_off(D0, 1, 0)>(vb), h1 = tr_read<v_rd_off(D0, 1, 1)>(vb);
    const s16x4 l2 = tr_read<v_rd_off(D0, 2, 0)>(vb), h2 = tr_read<v_rd_off(D0, 2, 1)>(vb), l3 = tr_read<v_rd_off(D0, 3, 0)>(vb), h3 = tr_read<v_rd_off(D0, 3, 1)>(vb);
    asm volatile("s_waitcnt lgkmcnt(0)" ::: "memory"); SBAR();
#define PK(L, H) (bf16x8){L[0], L[1], L[2], L[3], H[0], H[1], H[2], H[3]}
    od = __builtin_amdgcn_mfma_f32_32x32x16_bf16(pa0, PK(l0, h0), od, 0, 0, 0);
    od = __builtin_amdgcn_mfma_f32_32x32x16_bf16(pa1, PK(l1, h1), od, 0, 0, 0);
    od = __builtin_amdgcn_mfma_f32_32x32x16_bf16(pa2, PK(l2, h2), od, 0, 0, 0);
    od = __builtin_amdgcn_mfma_f32_32x32x16_bf16(pa3, PK(l3, h3), od, 0, 0, 0);
#undef PK
}
__device__ __forceinline__ void pv_d0(f32x16* o, int vb, bf16x8 pa0, bf16x8 pa1, bf16x8 pa2, bf16x8 pa3) {
    pv_one<0>(o[0], vb, pa0, pa1, pa2, pa3); pv_one<1>(o[1], vb, pa0, pa1, pa2, pa3); pv_one<2>(o[2], vb, pa0, pa1, pa2, pa3); pv_one<3>(o[3], vb, pa0, pa1, pa2, pa3);
}
__device__ __forceinline__ void qkt(f32x16& p0, f32x16& p1, const LAS unsigned char* Ks, const bf16x8* qr, int r32, int hi) {
    p0 = (f32x16){}; p1 = (f32x16){};
#pragma unroll
    for (int d0 = 0; d0 < 8; ++d0) { const int cb = (d0 * 16 + hi * 8) * 2;
        const bf16x8 b0 = *(const LAS bf16x8*)(Ks + KSWZ(r32, cb)); const bf16x8 b1 = *(const LAS bf16x8*)(Ks + KSWZ(32 + r32, cb));
        p0 = __builtin_amdgcn_mfma_f32_32x32x16_bf16(b0, qr[d0], p0, 0, 0, 0);
        p1 = __builtin_amdgcn_mfma_f32_32x32x16_bf16(b1, qr[d0], p1, 0, 0, 0); }
}
__device__ __forceinline__ void p_to_frags(const f32x16& p0, const f32x16& p1, bf16x8& pa0, bf16x8& pa1, bf16x8& pa2, bf16x8& pa3) {
#define PK4(P, BASE, OUT) do { unsigned a0 = cvt_pk_bf16(P[BASE + 0], P[BASE + 1]), a1 = cvt_pk_bf16(P[BASE + 2], P[BASE + 3]);   \
    unsigned b0 = cvt_pk_bf16(P[BASE + 4], P[BASE + 5]), b1 = cvt_pk_bf16(P[BASE + 6], P[BASE + 7]);                              \
    auto r0 = __builtin_amdgcn_permlane32_swap(a0, b0, false, false); auto r1 = __builtin_amdgcn_permlane32_swap(a1, b1, false, false); \
    u32x4 w = {r0[0], r1[0], r0[1], r1[1]}; OUT = __builtin_bit_cast(bf16x8, w); } while (0)
    PK4(p0, 0, pa0); PK4(p0, 8, pa1); PK4(p1, 0, pa2); PK4(p1, 8, pa3);
#undef PK4
}
__device__ __forceinline__ float half_swap_max(float v) { auto rr = __builtin_amdgcn_permlane32_swap(__float_as_uint(v), __float_as_uint(v), false, false); return fmaxf(__uint_as_float(rr[0]), __uint_as_float(rr[1])); }
__device__ __forceinline__ float half_swap_sum(float v) { auto rr = __builtin_amdgcn_permlane32_swap(__float_as_uint(v), __float_as_uint(v), false, false); return __uint_as_float(rr[0]) + __uint_as_float(rr[1]); }

__device__ __forceinline__ void stage_bf16(LAS unsigned char* lds, const bf16_t* kp, const bf16_t* vp, bool with_v, int tid_in) {
    int tid = tid_in; asm volatile("" : "+v"(tid));
    const int sr = tid >> 4, sc = (tid & 15) * 8; const unsigned o0 = (unsigned)(sr * 128 + sc) * 2u, o1 = o0 + 32u * 128u * 2u;
    const bf16x8 k0 = *(const bf16x8*)((const char*)kp + o0), k1 = *(const bf16x8*)((const char*)kp + o1);
    bf16x8 v0, v1;
    if (with_v) { v0 = *(const bf16x8*)((const char*)vp + o0); v1 = *(const bf16x8*)((const char*)vp + o1); }
    *(LAS bf16x8*)(lds + L_K + KSWZ(sr, sc * 2)) = k0; *(LAS bf16x8*)(lds + L_K + KSWZ(32 + sr, sc * 2)) = k1;
    if (with_v) { *(LAS bf16x8*)(lds + L_V + v_st(sr, sc)) = v0; *(LAS bf16x8*)(lds + L_V + v_st(32 + sr, sc)) = v1; }
}
__device__ __forceinline__ bf16x8 cvt8(const float* p) { const f32x4 a = *(const f32x4*)p, b = *(const f32x4*)(p + 4);
    u32x4 w; w.x = cvt_pk_bf16(a[0], a[1]); w.y = cvt_pk_bf16(a[2], a[3]); w.z = cvt_pk_bf16(b[0], b[1]); w.w = cvt_pk_bf16(b[2], b[3]); return __builtin_bit_cast(bf16x8, w); }
__device__ __forceinline__ void stage_f32(LAS unsigned char* lds, const float* kp, int tid_in) {
    int tid = tid_in; asm volatile("" : "+v"(tid));
    const int sr = tid >> 4, sc = (tid & 15) * 8; const unsigned o0 = (unsigned)(sr * 1024 + sc), o1 = o0 + 32u * 1024u;
    { const bf16x8 k0 = cvt8(kp + o0), k1 = cvt8(kp + o1);
      *(LAS bf16x8*)(lds + L_K + KSWZ(sr, sc * 2)) = k0; *(LAS bf16x8*)(lds + L_K + KSWZ(32 + sr, sc * 2)) = k1; }
    { const bf16x8 v0 = cvt8(kp + o0 + 512), v1 = cvt8(kp + o1 + 512);
      *(LAS bf16x8*)(lds + L_V + v_st(sr, sc)) = v0; *(LAS bf16x8*)(lds + L_V + v_st(32 + sr, sc)) = v1; }
}

__device__ __forceinline__ void mask_tile(f32x16& p0, f32x16& p1, int tpos, int pos0, int pstride, int dmax, bool rowok, float slope2, int hi) {
    const float NEG = -INFINITY;
#pragma unroll
    for (int r = 0; r < 16; ++r) { const int kk = (r & 3) + 8 * (r >> 2) + 4 * hi;
        const int d0 = tpos - (pos0 + pstride * kk), d1 = d0 - 32 * pstride;
        p0[r] = (rowok && d0 >= 0 && d0 < dmax) ? p0[r] - slope2 * (float)d0 : NEG;
        p1[r] = (rowok && d1 >= 0 && d1 < dmax) ? p1[r] - slope2 * (float)d1 : NEG; }
}
__device__ __forceinline__ void softmax_pv(f32x16& p0, f32x16& p1, float& m_reg, float& l_reg, f32x16* o, int vb, LAS float* wsf, int r32, int hi) {
    float pmax = p0[0];
#pragma unroll
    for (int r = 1; r < 16; ++r) pmax = fmaxf(pmax, p0[r]);
#pragma unroll
    for (int r = 0; r < 16; ++r) pmax = fmaxf(pmax, p1[r]);
    pmax = half_swap_max(pmax);
    const float mn = fmaxf(m_reg, pmax); const float alpha = __builtin_amdgcn_exp2f(m_reg - mn); m_reg = mn;
    float ps = 0.f;
#pragma unroll
    for (int r = 0; r < 16; ++r) { p0[r] = __builtin_amdgcn_exp2f(p0[r] - mn); p1[r] = __builtin_amdgcn_exp2f(p1[r] - mn); ps += p0[r] + p1[r]; }
    ps = half_swap_sum(ps);
    l_reg = l_reg * alpha + ps;
    if (__any(alpha < 1.f)) { if (hi == 0) wsf[r32] = alpha; LDS_WAIT();
#pragma unroll
        for (int r = 0; r < 16; ++r) { const float al = wsf[crow(r, hi)];
#pragma unroll
            for (int d = 0; d < 4; ++d) o[d][r] *= al; }
        LDS_WAIT(); }
    bf16x8 pa0, pa1, pa2, pa3; p_to_frags(p0, p1, pa0, pa1, pa2, pa3);
    pv_d0(o, vb, pa0, pa1, pa2, pa3);
}
template <int MODE>
__device__ __forceinline__ void flush_branch(const f32x16* o, float f, float* OF, bf16_t* OB, int mbase, int g, int nq, int wid, LAS float* wsf, int r32, int hi) {
    LDS_WAIT(); if (hi == 0) wsf[r32] = f; LDS_WAIT();
#pragma unroll
    for (int r = 0; r < 16; ++r) { const int rr = crow(r, hi), hr = rr >> 3, qrow = wid * 8 + (rr & 7); const float fr = wsf[rr];
        if (qrow < nq) { const size_t base = (size_t)(mbase + qrow) * D + (g * 4 + hr) * 128 + r32;
#pragma unroll
            for (int d0 = 0; d0 < 4; ++d0) { float v = fr * o[d0][r];
                if (MODE > 0) v += __hip_atomic_load(OF + base + 32 * d0, __ATOMIC_RELAXED, __HIP_MEMORY_SCOPE_AGENT);
                if (MODE < 2) OF[base + 32 * d0] = v; else OB[base + 32 * d0] = (bf16_t)(cvt_pk_bf16(v, 0.f) & 0xffffu); } } }
    LDS_WAIT();
}

__device__ __forceinline__ void glds16(const void* gsrc, unsigned lds_dst) { unsigned keep;
    asm volatile("s_mov_b32 %0, m0\n\ts_mov_b32 m0, %2\n\ts_nop 0\n\tglobal_load_lds_dwordx4 %1, off\n\ts_mov_b32 m0, %0" : "=&s"(keep) : "v"(gsrc), "s"(lds_dst) : "memory"); }
struct DmaMap { unsigned ko[2], vo[2]; };
__device__ __forceinline__ DmaMap dma_map(int wid, int lane) {
    DmaMap d;
#pragma unroll
    for (int i = 0; i < 2; ++i) { const int o = (wid * 2 + i) * 1024 + lane * 16;
        const int row = o >> 8, c = ((o >> 4) & 15) ^ (row & 7); d.ko[i] = (unsigned)(row * 128 + c * 8);
        const int sub = o >> 9, within = (o & 511) >> 1, kk = (sub >> 2) * 8 + (within >> 5), k = (kk & ~0xC) | ((kk & 4) << 1) | ((kk & 8) >> 1), cc = (sub & 3) * 32 + (within & 31);
        d.vo[i] = (unsigned)(k * 128 + cc); }
    return d;
}
__device__ __forceinline__ void dma_tile(unsigned ldsbuf  , const bf16_t* kp, const bf16_t* vp, bool with_v, const DmaMap& dm, int wid) {
    const unsigned d0 = __builtin_amdgcn_readfirstlane(ldsbuf + (unsigned)wid * 2048u);
    glds16(kp + dm.ko[0], d0); glds16(kp + dm.ko[1], d0 + 1024u);
    if (with_v) { glds16(vp + dm.vo[0], d0 + 16384u); glds16(vp + dm.vo[1], d0 + 16384u + 1024u); }
}

__device__ __forceinline__ void attn_unit(const Args& a, const Frame& F, int lj, bool samp, int b, int g, int qt) {
    unsigned char* ws = a.ws; LAS unsigned char* lds = F.lds;
    const int tid = F.tid, wid = F.wave, lane = F.lane, r32 = lane & 31, hi = lane >> 5;
    const int head = r32 >> 3, qi = r32 & 7, qq = wid * 8 + qi, nq = samp ? 8 : 64, bg = b * 4 + g;
    const bool rowok = qq < nq; const bool wactive = samp ? (wid == 0) : true;
    const int t0 = samp ? PAST : qt * 64, tpos = t0 + qq;
    const int mbase = samp ? MP + b * 8 : b * SEQ + qt * 64;
    const int mrow = mbase + (rowok ? qq : 0);
    const int hg = g * 4 + head;
    const float slope2 = exp2f(-0.5f * (float)(hg + 1)) * LOG2E;
    LAS float* wsf = (LAS float*)(lds + L_WSF) + wid * 64;
    LAS float* Pq = (LAS float*)(lds + L_PQ); const int pq_pitch = samp ? 1024 : 256;
    LAS u64* selm = (LAS u64*)(lds + L_SELM); LAS u64* wun = (LAS u64*)(lds + L_WUN);
    const unsigned lds0 = (unsigned)(uintptr_t)lds;
    const int vb0 = (int)lds0 + L_V + v_rd_base(lane);
    const DmaMap dm = dma_map(wid, lane);
    const float* QG = (const float*)(ws + WS_QG);
    bf16x8 qr[8];
    { const float* qp = QG + (size_t)mrow * QGP + hg * 128 + hi * 8; const float* qn = (const float*)a.in[19] + lj * 128 + hi * 8;
      f32x4 qa[8][2]; float ss = 0.f;
#pragma unroll
      for (int d0 = 0; d0 < 8; ++d0) { qa[d0][0] = *(const f32x4*)(qp + d0 * 16); qa[d0][1] = *(const f32x4*)(qp + d0 * 16 + 4);
#pragma unroll
          for (int e = 0; e < 4; ++e) ss += qa[d0][0][e] * qa[d0][0][e] + qa[d0][1][e] * qa[d0][1][e]; }
      ss = half_swap_sum(ss);
      const float sc = (1.0f / sqrtf(ss * (1.0f / 128.0f) + EPS)) * 0.08838834764831845f * LOG2E;
#pragma unroll
      for (int d0 = 0; d0 < 8; ++d0) { const f32x4 n0 = *(const f32x4*)(qn + d0 * 16), n1 = *(const f32x4*)(qn + d0 * 16 + 4); const f32x4 x0 = qa[d0][0] * n0 * sc, x1 = qa[d0][1] * n1 * sc;
          u32x4 w; w.x = cvt_pk_bf16(x0[0], x0[1]); w.y = cvt_pk_bf16(x0[2], x0[3]); w.z = cvt_pk_bf16(x1[0], x1[1]); w.w = cvt_pk_bf16(x1[2], x1[3]); qr[d0] = __builtin_bit_cast(bf16x8, w); } }
    float gate[3];
#pragma unroll
    for (int br = 0; br < 3; ++br) { const float x = QG[(size_t)mrow * QGP + 2048 + hg * 3 + br]; gate[br] = 1.0f / (1.0f + __expf(-x)); }

    f32x16 o[4]; float* OF = (float*)(ws + WS_OF32); bf16_t* OBp = (bf16_t*)(ws + WS_OB);
    const int ncv = samp ? NCS : (4 * qt + 3 < NCP ? 4 * qt + 3 : NCP); const int ntc = (ncv + 63) >> 6;
    const bf16_t* KC = (const bf16_t*)(ws + (samp ? WS_KCS : WS_KCP)) + (size_t)bg * (samp ? 1024 : 256) * 128;
    const bf16_t* VC = (const bf16_t*)(ws + (samp ? WS_VCS : WS_VCP)) + (size_t)bg * (samp ? 1024 : 256) * 128;
    float m_c = -1e30f, l_c = 0.f;
    __syncthreads();
    dma_tile(lds0, KC, nullptr, false, dm, wid);
    for (int tl = 0; tl < ntc; ++tl) {
        VM_WAIT(); __syncthreads();
        if (tl + 1 < ntc) dma_tile(lds0 + ((tl + 1) & 1) * L_BUF, KC + (size_t)(tl + 1) * 64 * 128, nullptr, false, dm, wid);
        if (wactive) { f32x16 p0, p1; qkt(p0, p1, lds + (tl & 1) * L_BUF + L_K, qr, r32, hi);
            mask_tile(p0, p1, tpos, 16 * 64 * tl + 31, 16, 1 << 30, rowok, slope2, hi);
            float pmax = p0[0];
#pragma unroll
            for (int r = 1; r < 16; ++r) pmax = fmaxf(pmax, p0[r]);
#pragma unroll
            for (int r = 0; r < 16; ++r) pmax = fmaxf(pmax, p1[r]);
            pmax = half_swap_max(pmax);
            const float mn = fmaxf(m_c, pmax); float ps = 0.f;
#pragma unroll
            for (int r = 0; r < 16; ++r) ps += __builtin_amdgcn_exp2f(p0[r] - mn) + __builtin_amdgcn_exp2f(p1[r] - mn);
            ps = half_swap_sum(ps);
            l_c = l_c * __builtin_amdgcn_exp2f(m_c - mn) + ps; m_c = mn; }
    }
#pragma unroll
    for (int d = 0; d < 4; ++d) o[d] = (f32x16){};
    const float inv_c = l_c > 0.f ? 1.0f / l_c : 0.f;
    __syncthreads();
    dma_tile(lds0, KC, VC, true, dm, wid);
    for (int tl = 0; tl < ntc; ++tl) {
        VM_WAIT(); __syncthreads();
        if (tl + 1 < ntc) dma_tile(lds0 + ((tl + 1) & 1) * L_BUF, KC + (size_t)(tl + 1) * 64 * 128, VC + (size_t)(tl + 1) * 64 * 128, true, dm, wid);
        if (wactive) { f32x16 p0, p1; qkt(p0, p1, lds + (tl & 1) * L_BUF + L_K, qr, r32, hi);
            mask_tile(p0, p1, tpos, 16 * 64 * tl + 31, 16, 1 << 30, rowok, slope2, hi);
#pragma unroll
            for (int r = 0; r < 16; ++r) { p0[r] = __builtin_amdgcn_exp2f(p0[r] - m_c) * inv_c; p1[r] = __builtin_amdgcn_exp2f(p1[r] - m_c) * inv_c; }
#pragma unroll
            for (int r = 0; r < 16; ++r) { float s0 = p0[r], s1 = p1[r]; s0 = xadd<8>(s0); s0 = xadd<16>(s0); s1 = xadd<8>(s1); s1 = xadd<16>(s1);
                if (head == 0 && rowok) { const int kk = crow(r, hi); Pq[qq * pq_pitch + tl * 64 + kk] = s0; Pq[qq * pq_pitch + tl * 64 + 32 + kk] = s1; } }
            bf16x8 pa0, pa1, pa2, pa3; p_to_frags(p0, p1, pa0, pa1, pa2, pa3);
            pv_d0(o, vb0 + (tl & 1) * L_BUF, pa0, pa1, pa2, pa3); }
    }
    if (wactive) flush_branch<0>(o, gate[0], OF, OBp, mbase, g, nq, wid, wsf, r32, hi);
    __syncthreads();
    if (!samp) dma_tile(lds0, (const bf16_t*)(ws + WS_KSEL) + (size_t)bg * SEQ * 128, (const bf16_t*)(ws + WS_VSEL) + (size_t)bg * SEQ * 128, true, dm, wid);
    const int nw = samp ? 5 : 1, nb = samp ? 257 : 64, nproc = ntc * 64;
    u64 myun[5] = {0ull, 0ull, 0ull, 0ull, 0ull};
    if (wactive) {
        for (int q2 = 0; q2 < 8; ++q2) {
            const int qq2 = wid * 8 + q2, t2 = t0 + qq2, cur = t2 >> 6;
            unsigned key[5]; bool vld[5];
#pragma unroll
            for (int w = 0; w < 5; ++w) { key[w] = 0u; vld[w] = false;
                if (w < nw) { const int jb = lane + 64 * w; float imp = 0.f;
#pragma unroll
                    for (int e = -1; e < 4; ++e) { const int c = 4 * jb + e; if (c >= 0 && c < nproc && jb < nb) imp += Pq[qq2 * pq_pitch + c]; }
                    const bool forced = (jb == 0) || (jb == cur) || (jb == cur - 1); vld[w] = (jb < nb) && (64 * jb <= t2);
                    const float val = vld[w] ? (forced ? imp + 1e4f : imp) : -1e30f; const unsigned bits = __float_as_uint(val);
                    key[w] = (jb < nb) ? ((bits & 0x80000000u) ? ~bits : (bits | 0x80000000u)) : 0u; } }
            unsigned T = 0u;
            for (int bit = 31; bit >= 0; --bit) { const unsigned cand = T | (1u << bit); int cnt = 0;
#pragma unroll
                for (int w = 0; w < 5; ++w) if (w < nw) cnt += __popcll(__ballot(key[w] >= cand));
                if (cnt >= 16) T = cand; }
            int ngt = 0;
#pragma unroll
            for (int w = 0; w < 5; ++w) if (w < nw) ngt += __popcll(__ballot(key[w] > T));
            int need = 16 - ngt, prev = 0;
#pragma unroll
            for (int w = 0; w < 5; ++w) if (w < nw) {
                const u64 eq = __ballot(key[w] == T); const int rank = prev + __popcll(eq & ((1ull << lane) - 1ull)); prev += __popcll(eq);
                const bool sel = (key[w] > T) || (key[w] == T && rank < need);
                const u64 mk = __ballot(sel && vld[w]);
                if (lane == 0) selm[qq2 * 5 + w] = mk;
                if (qq2 < nq) myun[w] |= mk; }
        }
    }
    if (lane == 0) {
#pragma unroll
        for (int w = 0; w < 5; ++w) if (w < nw) wun[wid * 5 + w] = myun[w]; }
    __syncthreads();
    float m_s = -1e30f, l_s = 0.f;
#pragma unroll
    for (int d = 0; d < 4; ++d) o[d] = (f32x16){};
    if (!samp) {
        const bf16_t* KS = (const bf16_t*)(ws + WS_KSEL) + (size_t)bg * SEQ * 128; const bf16_t* VS = (const bf16_t*)(ws + WS_VSEL) + (size_t)bg * SEQ * 128;
        u64 U = 0ull;
#pragma unroll
        for (int x = 0; x < 8; ++x) U |= wun[x * 5];
        { const unsigned ulo = __builtin_amdgcn_readfirstlane((unsigned)U), uhi = __builtin_amdgcn_readfirstlane((unsigned)(U >> 32)); U = ((u64)uhi << 32) | ulo; }
        const u64 mysel = rowok ? selm[qq * 5] : 0ull;
        U |= 1ull;
        int cur = 0, it = 0; U &= U - 1ull;
        while (cur >= 0) {
            const int nxt = U ? __builtin_ctzll(U) : -1; U &= U - 1ull;
            VM_WAIT(); __syncthreads();
            if (nxt >= 0) dma_tile(lds0 + ((it + 1) & 1) * L_BUF, KS + (size_t)nxt * 64 * 128, VS + (size_t)nxt * 64 * 128, true, dm, wid);
            { f32x16 p0, p1; qkt(p0, p1, lds + (it & 1) * L_BUF + L_K, qr, r32, hi);
              mask_tile(p0, p1, tpos, 64 * cur, 1, 1 << 30, rowok && ((mysel >> cur) & 1ull), slope2, hi);
              softmax_pv(p0, p1, m_s, l_s, o, vb0 + (it & 1) * L_BUF, wsf, r32, hi); }
            cur = nxt; ++it;
        }
    } else {
        const float* cache = (const float*)a.in[3]; const int* pt = (const int*)a.in[4] + b * 128;
        for (int w = 0; w < nw; ++w) {
            u64 U = 0ull;
#pragma unroll
            for (int x = 0; x < 8; ++x) U |= wun[x * 5 + w];
            { const unsigned ulo = __builtin_amdgcn_readfirstlane((unsigned)U), uhi = __builtin_amdgcn_readfirstlane((unsigned)(U >> 32)); U = ((u64)uhi << 32) | ulo; }
            const u64 mysel = rowok ? selm[qq * 5 + w] : 0ull;
            while (U) {
                const int bit = __builtin_ctzll(U); U &= U - 1ull; const int jb = 64 * w + bit;
                __syncthreads();
                if (jb < 256) stage_f32(lds, cache + ((size_t)pt[jb >> 1] * 128 + (jb & 1) * 64) * 1024 + g * 128, tid);
                else stage_bf16(lds, (const bf16_t*)(ws + WS_KSELNS) + (size_t)bg * 64 * 128, (const bf16_t*)(ws + WS_VSELNS) + (size_t)bg * 64 * 128, true, tid);
                __syncthreads();
                if (wactive) { f32x16 p0, p1; qkt(p0, p1, lds + L_K, qr, r32, hi);
                    mask_tile(p0, p1, tpos, 64 * jb, 1, 1 << 30, rowok && ((mysel >> bit) & 1ull), slope2, hi);
                    softmax_pv(p0, p1, m_s, l_s, o, vb0, wsf, r32, hi); }
            }
        }
    }
    if (wactive) flush_branch<1>(o, l_s > 0.f ? gate[1] / l_s : 0.f, OF, OBp, mbase, g, nq, wid, wsf, r32, hi);
    float m_w = -1e30f, l_w = 0.f;
#pragma unroll
    for (int d = 0; d < 4; ++d) o[d] = (f32x16){};
    {
        const bf16_t* KW = samp ? (const bf16_t*)(ws + WS_KWINS) + (size_t)bg * 576 * 128 : (const bf16_t*)(ws + WS_KWIN) + (size_t)bg * SEQ * 128;
        const bf16_t* VW = samp ? (const bf16_t*)(ws + WS_VWINS) + (size_t)bg * 576 * 128 : (const bf16_t*)(ws + WS_VWIN) + (size_t)bg * SEQ * 128;
        const int jlo = samp ? 0 : (qt >= 8 ? qt - 8 : 0), jhi = samp ? 8 : qt, posb = samp ? PAST - 512 : 0;
        __syncthreads();
        dma_tile(lds0, KW + (size_t)jlo * 64 * 128, VW + (size_t)jlo * 64 * 128, true, dm, wid);
        for (int jt = jlo; jt <= jhi; ++jt) { const int it = jt - jlo;
            VM_WAIT(); __syncthreads();
            if (jt < jhi) dma_tile(lds0 + ((it + 1) & 1) * L_BUF, KW + (size_t)(jt + 1) * 64 * 128, VW + (size_t)(jt + 1) * 64 * 128, true, dm, wid);
            if (wactive) { f32x16 p0, p1; qkt(p0, p1, lds + (it & 1) * L_BUF + L_K, qr, r32, hi);
                mask_tile(p0, p1, tpos, posb + 64 * jt, 1, 512, rowok, slope2, hi);
                softmax_pv(p0, p1, m_w, l_w, o, vb0 + (it & 1) * L_BUF, wsf, r32, hi); }
        }
    }
    if (wactive) flush_branch<2>(o, l_w > 0.f ? gate[2] / l_w : 0.f, OF, OBp, mbase, g, nq, wid, wsf, r32, hi);
    __syncthreads();
}

__device__ __forceinline__ void attn_phase(const Args& a, const Frame& F, int lj) {
    const int G = F.G;
    if (G == 256) { if ((F.vcu & 63) < 8) { const int us = (F.vcu >> 6) * 8 + (F.vcu & 63); attn_unit(a, F, lj, true, us >> 2, us & 3, 0); } }
    else for (int us = F.vcu; us < 32; us += G) attn_unit(a, F, lj, true, us >> 2, us & 3, 0);
    for (int rnd = 0; rnd * G < 512; ++rnd) {
        const int id = (rnd & 1) ? (rnd + 1) * G - 1 - F.vcu : rnd * G + F.vcu;
        if (id < 512) attn_unit(a, F, lj, false, (id >> 6) >> 2, (id >> 6) & 3, id & 63);
    }
}
}

#ifndef PHMASK
#define PHMASK 0xFFFFFFFFu
#endif
#define PH(n) ((PHMASK >> (n)) & 1u)
__global__ void __launch_bounds__(NTHR, 2) mega_fwd(Args a) {
    extern __shared__ __attribute__((aligned(16))) unsigned char lds_raw[];
    Frame F; F.lds = (LAS unsigned char*)lds_raw; F.tid = threadIdx.x; F.lane = F.tid & 63; F.wave = __builtin_amdgcn_readfirstlane(F.tid >> 6);
    int wv0 = F.wave; asm volatile("" : "+s"(wv0));
    F.G = gridDim.x; { const int bx = blockIdx.x; F.vcu = (F.G % 8 == 0) ? (bx % 8) * (F.G / 8) + bx / 8 : bx; }
    unsigned char* ws = a.ws;
    volatile LAS unsigned* MISC = (volatile LAS unsigned*)(F.lds + MISC_OFF);
    for (int u = F.tid; u < (LDS_BYTES - LDSCTL_OFF) / 4; u += NTHR) ((LAS unsigned*)(F.lds + LDSCTL_OFF))[u] = 0u;
    __syncthreads();
    XcdBarrier bar = xcd_barrier_post((unsigned*)(ws + WS_CTL) + CW_BAR, MISC + 8, F.tid);
    const int cblk = (int)blockIdx.x;
#define RELAUNDER() do { int l_ = lane_id(); asm volatile("" : "+v"(l_)); F.tid = wv0 * 64 + l_; F.lane = l_; F.wave = wv0; asm volatile("" : "+s"(ws)); } while (0)

    RELAUNDER(); if (PH(0)) p0_prologue(a, F);
    xcd_barrier(bar, F.tid);

    for (int l = 0; l < 4; ++l) {
        bf16_t* XB = (bf16_t*)(ws + WS_XB);
        float* rowp_ffn = (float*)(ws + WS_ROWP + (size_t)(2 * l + 1) * ROWP_STRIDE);
        if (l < 2) {
            RELAUNDER(); if (PH(1)) pool_pass(a, F, l);
            xcd_barrier(bar, F.tid);
            RELAUNDER(); if (PH(2)) { SchedMix S; S.o.init(NTM - 1, 8, F.G, cblk);
              EpiResid E{XB, nullptr, rowp_ffn, (const float*)a.in[11] + l * D, MR};
              pg8::gemm_phase<EpiResid, SchedMix, true>(F.lds, F.tid, (const char*)(ws + WS_POOLED), (const char*)(ws + WS_WPOOL) + (size_t)l * 4 * 512 * 512 * 2, D, 512, 512, S, E);
              for (int nb = F.vcu; nb < 32; nb += F.G) { const int g = nb >> 3;
                  mini_resid(F.lds, F.tid, (const bf16_t*)(ws + WS_POOLED) + (size_t)MP * D + g * 512, D, (const bf16_t*)(ws + WS_WPOOL) + ((size_t)(l * 4 + g) * 512 + (nb & 7) * 64) * 512, 512, 512, nb,
                             XB, nullptr, rowp_ffn, (const float*)a.in[11] + l * D, MP); } }
            xcd_barrier(bar, F.tid);
        } else {
            const int lj = l - 2;
            RELAUNDER(); if (PH(3)) { SchedPlain S; S.o.init(NTM, lj == 0 ? 21 : 9, F.G, cblk); S.astep = (size_t)256 * D * 2; S.bstep = (size_t)256 * D * 2;
              const float* rowp_mix = (const float*)(ws + WS_ROWP + (size_t)(2 * l) * ROWP_STRIDE);
              EpiF32 E{rowp_mix, lj == 0 ? (float*)(ws + WS_KV) : (float*)(ws + WS_QG), lj == 0 ? KVW : QGP, lj == 0 ? 12 : 1000, (float*)(ws + WS_QG), QGP};
              pg8::gemm_phase<EpiF32, SchedPlain, true>(F.lds, F.tid, (const char*)XB, (const char*)(ws + (lj == 0 ? WS_WKVQG : WS_WQG1)), D, D, D, S, E); }
            xcd_barrier(bar, F.tid);
            if (lj == 0) {
                RELAUNDER(); if (PH(4)) kvpost_pass(a, F);
                xcd_barrier(bar, F.tid);
                RELAUNDER(); if (PH(5)) { SchedCmp S; S.o.init(CMP_ROWS / 256, 1, F.G, cblk);
                  EpiF32 E{nullptr, (float*)(ws + WS_PCMP), 256, 1000, nullptr, 0};
                  pg8::gemm_phase<EpiF32, SchedCmp, true>(F.lds, F.tid, (const char*)(ws + WS_ACMP), (const char*)(ws + WS_W1CAT), 2048, 2048, 2048, S, E); }
                xcd_barrier(bar, F.tid);
                RELAUNDER(); if (PH(6)) cmppost_pass(a, F);
                xcd_barrier(bar, F.tid);
            }
            RELAUNDER(); if (PH(7)) nsa::attn_phase(a, F, lj);
            xcd_barrier(bar, F.tid);
            RELAUNDER(); if (PH(8)) { SchedPlain S; S.o.init(NTM - 1, 8, F.G, cblk); S.astep = (size_t)256 * D * 2; S.bstep = (size_t)256 * D * 2;
              EpiResid E{XB, nullptr, rowp_ffn, nullptr, MR};
              pg8::gemm_phase<EpiResid, SchedPlain, true>(F.lds, F.tid, (const char*)(ws + WS_OB), (const char*)(ws + WS_WO) + (size_t)lj * D * D * 2, D, D, D, S, E);
              for (int nb = F.vcu; nb < 32; nb += F.G)
                  mini_resid(F.lds, F.tid, (const bf16_t*)(ws + WS_OB) + (size_t)MP * D, D, (const bf16_t*)(ws + WS_WO) + (size_t)lj * D * D + (size_t)nb * 64 * D, D, D, nb, XB, nullptr, rowp_ffn, nullptr, MP); }
            xcd_barrier(bar, F.tid);
        }
        RELAUNDER(); if (PH(9)) { SchedPlain S; S.o.init(NTM, 44, F.G, cblk); S.astep = (size_t)256 * D * 2; S.bstep = (size_t)256 * D * 2;
          EpiConv E{rowp_ffn, (bf16_t*)(ws + WS_ACT), (float*)(ws + WS_EDGE), a.out + O_CONVP + (size_t)l * NBP * 2 * FF2, a.out + O_CONVS + (size_t)l * NBS * 2 * FF2,
                    (const float*)a.in[22] + (size_t)l * 3 * FF2, (const float*)a.in[23] + (size_t)l * FF2, (const float*)a.in[7] + (size_t)l * NBS * 2 * FF2, (LAS float*)(F.lds + RING_BYTES + 1024)};
          pg8::gemm_phase<EpiConv, SchedPlain, true>(F.lds, F.tid, (const char*)XB, (const char*)(ws + WS_WIN) + (size_t)l * FF2 * D * 2, D, D, D, S, E); }
        xcd_barrier(bar, F.tid);
        RELAUNDER(); if (PH(11)) { SchedPlain S; S.o.init(NTM - 1, 8, F.G, cblk); S.astep = (size_t)256 * FF * 2; S.bstep = (size_t)256 * FF * 2;
          float* rowp_next = l < 3 ? (float*)(ws + WS_ROWP + (size_t)(2 * l + 2) * ROWP_STRIDE) : nullptr;
          { Unit u0; for (int i = 0; S.next(i, u0); ++i) act_fixup(u0.pm, F.tid, (const float*)(ws + WS_EDGE), (bf16_t*)(ws + WS_ACT), (const float*)a.in[22] + (size_t)l * 3 * FF2, (const float*)a.in[23] + (size_t)l * FF2);
            VM_WAIT(); __syncthreads(); }
          EpiResid E{XB, l < 3 ? nullptr : a.out, rowp_next, nullptr, MR};
          pg8::gemm_phase<EpiResid, SchedPlain, true>(F.lds, F.tid, (const char*)(ws + WS_ACT), (const char*)(ws + WS_WOUT) + (size_t)l * D * FF * 2, FF, FF, FF, S, E);
          for (int nb = F.vcu; nb < 32; nb += F.G)
              mini_resid(F.lds, F.tid, (const bf16_t*)(ws + WS_ACT) + (size_t)MP * FF, FF, (const bf16_t*)(ws + WS_WOUT) + (size_t)l * D * FF + (size_t)nb * 64 * FF, FF, FF, nb,
                         XB, l < 3 ? nullptr : a.out, rowp_next, nullptr, MP); }
        if (l < 3) xcd_barrier(bar, F.tid);
    }
}

extern "C" void kernel_launch(void* const* d_in, const int* in_sizes, int n_in, void* d_out, int out_size, void* d_ws, size_t ws_size, hipStream_t stream) {
    static int grid = 0;
    if (grid == 0) {
        if (n_in != 25 || out_size != (int)O_END || ws_size < WS_END) { fprintf(stderr, "kernel_launch: unexpected shapes: n_in %d out %d ws %zu (need %zu)\n", n_in, out_size, ws_size, (size_t)WS_END); grid = -1; return; }
        int dev = 0, cus = 0, per_cu = 0;
        if (hipGetDevice(&dev) != hipSuccess || hipDeviceGetAttribute(&cus, hipDeviceAttributeMultiprocessorCount, dev) != hipSuccess) { grid = -1; return; }
        if (hipFuncSetAttribute((const void*)mega_fwd, hipFuncAttributeMaxDynamicSharedMemorySize, LDS_BYTES) != hipSuccess) { fprintf(stderr, "kernel_launch: hipFuncSetAttribute failed\n"); grid = -1; return; }
        if (hipOccupancyMaxActiveBlocksPerMultiprocessor(&per_cu, (const void*)mega_fwd, NTHR, LDS_BYTES) != hipSuccess || per_cu < 1) fprintf(stderr, "kernel_launch: occupancy query says %d\n", per_cu);
        (void)hipGetLastError();
        grid = cus;
    }
    if (grid < 0) return;
    (void)hipMemsetAsync((char*)d_ws + WS_CTL, 0, CTL_ZERO_BYTES, stream);
    Args a{};
    for (int i = 0; i < 25; ++i) a.in[i] = d_in[i];
    a.out = (float*)d_out; a.ws = (unsigned char*)d_ws;
    hipLaunchKernelGGL(mega_fwd, dim3(grid), dim3(NTHR), LDS_BYTES, stream, a);
    const hipError_t le = hipPeekAtLastError();
    if (le != hipSuccess) fprintf(stderr, "kernel_launch: launch failed: %s\n", hipGetErrorName(le));
}
```
